# Optimizing an MI355X kernel written in HIP

```python
import math
import jax
import jax.numpy as jnp
from jax import lax
import numpy as np

D_MODEL = 1024
BATCH = 2
SEQ = 8192
DEPTH = 4

GRID_W = 64
CTX_LEN = 256
N_MIXERS = 3
N_A = (DEPTH + 2) // N_MIXERS
N_B = (DEPTH + 1) // N_MIXERS
N_C = DEPTH // N_MIXERS
NORM_EPS = 1e-6

RW_HEAD = 64
RW_HEADS = D_MODEL // RW_HEAD
RW_DECAY_LORA = 64
RW_AAA_LORA = 64
RW_GATE_LORA = 160
RW_LNX_EPS = 6.4e-4

ML_HEADS = 4
ML_QK = D_MODEL // (2 * ML_HEADS)
ML_V = D_MODEL // ML_HEADS
ML_CHUNK = 128
ML_IN = 2 * ML_HEADS * ML_QK + ML_HEADS * ML_V + D_MODEL + 4 * ML_HEADS

DA_HEADS = 8
DA_HEAD = D_MODEL // (2 * DA_HEADS)
DA_QBLOCK = 128
ROPE_BASE = 10000.0

FFN_HIDDEN = 2816
CONV_W = 3

kernel_name = "hybrid_rwkv7_mlstm_diffattn_adaln"


def _prev(x):
    return jnp.pad(x, ((0, 0), (1, 0), (0, 0)))[:, :-1]


def _next(x):
    return jnp.pad(x, ((0, 0), (0, 1), (0, 0)))[:, 1:]


def rms_norm(x, g):
    xf = x.astype(jnp.float32)
    y = xf * lax.rsqrt(jnp.mean(xf * xf, axis=-1, keepdims=True) + NORM_EPS)
    return (y * g.astype(jnp.float32)).astype(x.dtype)


def conv_ffn(h, w_in, conv_w, conv_b, w_out):
    val, gate = jnp.split(h @ w_in, 2, axis=-1)
    gate = conv_w[0] * _prev(gate) + conv_w[1] * gate + conv_w[2] * _next(gate) + conv_b
    return (jax.nn.gelu(gate) * val) @ w_out


def rwkv7_scan(r, w, k, v, kk, a, state, reverse):
    def step(S, inp):
        r_t, w_t, k_t, v_t, kk_t, a_t = inp
        sa = jnp.einsum('bhvk,bhk->bhv', S, kk_t)
        S = (S * w_t[:, :, None, :] - sa[..., None] * (kk_t * a_t)[:, :, None, :]
             + v_t[..., None] * k_t[:, :, None, :])
        return S, jnp.einsum('bhvk,bhk->bhv', S, r_t)
    xs = tuple(jnp.moveaxis(t, 1, 0) for t in (r, w, k, v, kk, a))
    S, ys = lax.scan(step, state, xs, reverse=reverse)
    return jnp.moveaxis(ys, 0, 1), S


def rwkv7_mixer(h_lat, h_ctx, mix, w_rkv, w0, w1, w2, a0, a1, a2, g1, g2,
                k_k, k_a, r_k, lnx_g, lnx_b, w_out, with_ctx):
    H, N = RW_HEADS, RW_HEAD
    f32 = jnp.float32

    def lora(xin, p1, p2, act):
        return jnp.einsum('zbnl,zld->zbnd', act(jnp.einsum('bnd,zdl->zbnl', xin, p1)), p2)

    def prep(h):
        B, n, D = h.shape
        xx = 0.5 * (_prev(h) + _next(h)) - h
        xs = h[:, :, None, :] + xx[:, :, None, :] * mix
        rkv = jnp.einsum('bnjd,jde->bnje', xs[:, :, :3], w_rkv)
        r, k, v = rkv[:, :, 0], rkv[:, :, 1], rkv[:, :, 2]
        w_pre = (w0[:, None, None, :] + lora(xs[:, :, 3], w1, w2, jnp.tanh)).astype(f32)
        decay = jnp.exp(-jnp.exp(-jax.nn.softplus(-w_pre) - 0.5))
        a = jax.nn.sigmoid((a0[:, None, None, :]
                            + lora(xs[:, :, 4], a1, a2, lambda t: t)).astype(f32))
        g = jax.nn.sigmoid(xs[:, :, 5] @ g1) @ g2
        kk = (k * k_k).astype(f32).reshape(B, n, H, N)
        kk = kk / jnp.maximum(jnp.linalg.norm(kk, axis=-1, keepdims=True), 1e-12)
        kd = k.astype(f32) * (1.0 + (a - 1.0) * k_a.astype(f32))
        split = lambda t: t.reshape(t.shape[:-1] + (H, N))
        return (split(r.astype(f32)), split(decay), split(kd), split(v.astype(f32)),
                kk, split(a), g)

    def post(y, pr, h):
        r, _, kd, v, _, _, g = pr
        B, n, D = h.shape
        mu = jnp.mean(y, axis=-1, keepdims=True)
        var = jnp.mean(jnp.square(y - mu), axis=-1, keepdims=True)
        y = ((y - mu) * lax.rsqrt(var + RW_LNX_EPS)).reshape(B, n, D) * lnx_g + lnx_b
        bonus = jnp.sum(jnp.sum(r * kd * r_k, axis=-1, keepdims=True) * v, axis=0)
        return ((y + bonus.reshape(B, n, D)) * g).astype(h.dtype) @ w_out

    lat, ctx = prep(h_lat), prep(h_ctx)
    state0 = jnp.zeros((h_lat.shape[0], H, N, N), f32)
    ys_lat, ys_ctx = [], []
    for d, rev in ((0, False), (1, True)):
        yc, s_ctx = rwkv7_scan(ctx[0], ctx[1][d], ctx[2][d], ctx[3], ctx[4], ctx[5][d], state0, rev)
        yl, _ = rwkv7_scan(lat[0], lat[1][d], lat[2][d], lat[3], lat[4], lat[5][d], s_ctx, rev)
        ys_lat.append(yl)
        ys_ctx.append(yc)
    out_lat = post(ys_lat[0] + ys_lat[1], lat, h_lat)
    out_ctx = post(ys_ctx[0] + ys_ctx[1], ctx, h_ctx) if with_ctx else None
    return out_lat, out_ctx


def mlstm_chunked(q, k, v, li, lf, state):
    B, H, L, dk = q.shape
    dv = v.shape[-1]
    T = ML_CHUNK
    nc = L // T
    qc = q.reshape(B, H, nc, T, dk)
    kc = k.reshape(B, H, nc, T, dk)
    vc = v.reshape(B, H, nc, T, dv)
    lic = li.reshape(B, H, nc, T)
    b = jnp.cumsum(lf.reshape(B, H, nc, T), axis=-1)
    b_end = b[..., -1]
    g_end = b_end[..., None] - b + lic
    m_loc = jnp.max(g_end, axis=-1)
    w_end = jnp.exp(g_end - m_loc[..., None])
    C_loc = jnp.einsum('bhcsk,bhcsv->bhckv', kc * w_end[..., None], vc)
    n_loc = jnp.einsum('bhcs,bhcsk->bhck', w_end, kc)

    def step(carry, inp):
        C, n, m = carry
        Cl, nl, ml, be = inp
        m_new = jnp.maximum(be + m, ml)
        a = jnp.exp(be + m - m_new)
        e = jnp.exp(ml - m_new)
        new = (a[..., None, None] * C + e[..., None, None] * Cl,
               a[..., None] * n + e[..., None] * nl, m_new)
        return new, (C, n, m)

    xs = tuple(jnp.moveaxis(t, 2, 0) for t in (C_loc, n_loc, m_loc, b_end))
    final, starts = lax.scan(step, state, xs)
    C0, n0, m0 = (jnp.moveaxis(t, 0, 2) for t in starts)
    tri = jnp.tril(jnp.ones((T, T), dtype=bool))
    d_log = jnp.where(tri, b[..., :, None] - b[..., None, :] + lic[..., None, :], -jnp.inf)
    inter = b + m0[..., None]
    m_t = jnp.maximum(jnp.max(d_log, axis=-1), inter)
    p = jnp.exp(d_log - m_t[..., None]) * jnp.einsum('bhctk,bhcsk->bhcts', qc, kc)
    e_inter = jnp.exp(inter - m_t)
    num = (jnp.einsum('bhcts,bhcsv->bhctv', p, vc)
           + e_inter[..., None] * jnp.einsum('bhctk,bhckv->bhctv', qc, C0))
    den = jnp.sum(p, axis=-1) + e_inter * jnp.einsum('bhctk,bhck->bhct', qc, n0)
    h = num / jnp.maximum(jnp.abs(den), jnp.exp(-m_t))[..., None]
    return h.reshape(B, H, L, dv), final


def mlstm_mixer(h_lat, h_ctx, w_in, b_in, norm_g, w_out, with_ctx):
    H, dk, dv = ML_HEADS, ML_QK, ML_V
    f32 = jnp.float32
    cuts = [H * dk, 2 * H * dk, 2 * H * dk + H * dv, 2 * H * dk + H * dv + D_MODEL]

    def prep(h):
        B, n, _ = h.shape
        q, k, v, o, gt = jnp.split(h @ w_in + b_in, cuts, axis=-1)
        heads = lambda t, e: jnp.transpose(t.reshape(B, n, H, e), (0, 2, 1, 3)).astype(f32)
        gt = jnp.transpose(gt.astype(f32).reshape(B, n, 2, 2, H), (2, 3, 0, 4, 1))
        return (heads(q, dk), heads(k, dk) * (dk ** -0.5), heads(v, dv),
                jax.nn.sigmoid(o), gt[:, 0], jax.nn.log_sigmoid(gt[:, 1]))

    def post(hsum, o):
        B, _, n, _ = hsum.shape
        hn = hsum * lax.rsqrt(jnp.mean(hsum * hsum, axis=-1, keepdims=True) + NORM_EPS)
        hn = jnp.transpose(hn, (0, 2, 1, 3)).reshape(B, n, D_MODEL)
        return (hn * norm_g * o).astype(o.dtype) @ w_out

    lat, ctx = prep(h_lat), prep(h_ctx)
    B = h_lat.shape[0]
    state0 = (jnp.zeros((B, H, dk, dv), f32), jnp.zeros((B, H, dk), f32), jnp.zeros((B, H), f32))
    hs_lat, hs_ctx = [], []
    for d in range(2):
        fl = (lambda t: t) if d == 0 else (lambda t: jnp.flip(t, axis=2))
        hc, s_ctx = mlstm_chunked(fl(ctx[0]), fl(ctx[1]), fl(ctx[2]), fl(ctx[4][d]), fl(ctx[5][d]), state0)
        hl, _ = mlstm_chunked(fl(lat[0]), fl(lat[1]), fl(lat[2]), fl(lat[4][d]), fl(lat[5][d]), s_ctx)
        hs_lat.append(fl(hl))
        hs_ctx.append(fl(hc))
    out_lat = post(hs_lat[0] + hs_lat[1], lat[3])
    out_ctx = post(hs_ctx[0] + hs_ctx[1], ctx[3]) if with_ctx else None
    return out_lat, out_ctx


def axial_rope(n, dim):
    rows = n // GRID_W
    row = jnp.repeat(jnp.arange(rows), GRID_W).astype(jnp.float32)
    col = jnp.tile(jnp.arange(GRID_W), rows).astype(jnp.float32)
    nf = dim // 4
    inv = jnp.power(ROPE_BASE, -jnp.arange(nf, dtype=jnp.float32) / nf)
    ang = jnp.concatenate([row[:, None] * inv, col[:, None] * inv], axis=-1)
    return jnp.cos(ang), jnp.sin(ang)


def apply_rope(x, cos, sin):
    half = x.shape[-1] // 2
    x1, x2 = x[..., :half], x[..., half:]
    cos = cos[None, :, None, None, :].astype(x.dtype)
    sin = sin[None, :, None, None, :].astype(x.dtype)
    return jnp.concatenate([x1 * cos - x2 * sin, x1 * sin + x2 * cos], axis=-1)


def diff_attention_mixer(h_lat, h_ctx, w_qkv, lam, norm_g, w_out, lambda_init, with_ctx):
    H, d = DA_HEADS, DA_HEAD
    f32 = jnp.float32
    B, S, _ = h_lat.shape

    def proj(h):
        n = h.shape[1]
        q, k, v = jnp.split(h @ w_qkv, 3, axis=-1)
        return q.reshape(B, n, H, 2, d), k.reshape(B, n, H, 2, d), v.reshape(B, n, H, 2 * d)

    ql, kl, vl = proj(h_lat)
    qc, kc, vc = proj(h_ctx)
    cos, sin = axial_rope(S, d)
    ql, kl = apply_rope(ql, cos, sin), apply_rope(kl, cos, sin)
    lam = lam.astype(f32)
    lam_full = jnp.exp(jnp.sum(lam[0] * lam[1])) - jnp.exp(jnp.sum(lam[2] * lam[3])) + lambda_init

    def attend(q, k, v):
        s = jnp.einsum('bqhmd,bkhmd->bhmqk', q, k).astype(f32) * (d ** -0.5)
        p = jax.nn.softmax(s, axis=-1)
        p = p[:, :, 0] - lam_full * p[:, :, 1]
        return jnp.einsum('bhqk,bkhe->bqhe', p.astype(v.dtype), v)

    def post(o):
        n = o.shape[1]
        of = o.astype(f32)
        of = of * lax.rsqrt(jnp.mean(of * of, axis=-1, keepdims=True) + 1e-5) * norm_g * (1.0 - lambda_init)
        return of.astype(o.dtype).reshape(B, n, D_MODEL) @ w_out

    k_all = jnp.concatenate([kl, kc], axis=1)
    v_all = jnp.concatenate([vl, vc], axis=1)
    nb = S // DA_QBLOCK
    qb = jnp.transpose(ql.reshape(B, nb, DA_QBLOCK, H, 2, d), (1, 0, 2, 3, 4, 5))
    ol = lax.map(lambda q: attend(q, k_all, v_all), qb)
    ol = jnp.transpose(ol, (1, 0, 2, 3, 4)).reshape(B, S, H, 2 * d)
    out_lat = post(ol)
    out_ctx = post(attend(qc, kc, vc)) if with_ctx else None
    return out_lat, out_ctx


def setup_inputs(seed: int = 0) -> dict:
    key = jax.random.key(seed)
    keys = iter(jax.random.split(key, 48))
    f32 = jnp.float32
    D, F = D_MODEL, FFN_HIDDEN
    s = D ** -0.5

    def nrm(shape, scale):
        return jax.random.normal(next(keys), shape, f32) * scale

    def unif(shape, lo, hi):
        return jax.random.uniform(next(keys), shape, f32, lo, hi)

    ml_b_main = nrm((N_B, ML_IN - 4 * ML_HEADS), 0.02)
    ml_b_i = nrm((N_B, 2, ML_HEADS), 0.1)
    ml_b_f = unif((N_B, 2, ML_HEADS), 3.0, 6.0)
    ml_b_gate = jnp.stack([ml_b_i, ml_b_f], axis=2).reshape(N_B, 4 * ML_HEADS)

    return {
        "x": nrm((BATCH, SEQ, D), 1.0),
        "c": nrm((BATCH, D), 1.0),
        "ctx": nrm((BATCH, CTX_LEN, D), 1.0),
        "c_ctx": nrm((D,), 1.0),
        "ada_w": nrm((DEPTH, D, 6 * D), 0.5 * s),
        "ada_b": nrm((DEPTH, 6 * D), 0.02),
        "norm1_g": 1.0 + nrm((DEPTH, D), 0.02),
        "norm2_g": 1.0 + nrm((DEPTH, D), 0.02),
        "ffn_w_in": nrm((DEPTH, D, 2 * F), s),
        "ffn_conv_w": nrm((DEPTH, CONV_W, F), CONV_W ** -0.5),
        "ffn_conv_b": nrm((DEPTH, F), 0.02),
        "ffn_w_out": nrm((DEPTH, F, D), F ** -0.5),
        "ra_mix": unif((N_A, 6, D), 0.0, 1.0),
        "ra_w_rkv": nrm((N_A, 3, D, D), s),
        "ra_w0": unif((N_A, 2, D), -6.0, -1.0),
        "ra_w1": nrm((N_A, 2, D, RW_DECAY_LORA), 0.1 * s),
        "ra_w2": nrm((N_A, 2, RW_DECAY_LORA, D), 0.1 * RW_DECAY_LORA ** -0.5),
        "ra_a0": nrm((N_A, 2, D), 0.1),
        "ra_a1": nrm((N_A, 2, D, RW_AAA_LORA), 0.1 * s),
        "ra_a2": nrm((N_A, 2, RW_AAA_LORA, D), RW_AAA_LORA ** -0.5),
        "ra_g1": nrm((N_A, D, RW_GATE_LORA), s),
        "ra_g2": nrm((N_A, RW_GATE_LORA, D), RW_GATE_LORA ** -0.5),
        "ra_k_k": 0.85 + nrm((N_A, D), 0.02),
        "ra_k_a": 1.0 + nrm((N_A, D), 0.02),
        "ra_r_k": nrm((N_A, RW_HEADS, RW_HEAD), 0.1),
        "ra_lnx_g": 1.0 + nrm((N_A, D), 0.02),
        "ra_lnx_b": nrm((N_A, D), 0.02),
        "ra_w_out": nrm((N_A, D, D), s),
        "ml_w_in": nrm((N_B, D, ML_IN), s),
        "ml_b_in": jnp.concatenate([ml_b_main, ml_b_gate], axis=-1),
        "ml_norm_g": 1.0 + nrm((N_B, D), 0.02),
        "ml_w_out": nrm((N_B, D, D), s),
        "da_w_qkv": nrm((N_C, D, 3 * D), s),
        "da_lambda": nrm((N_C, 4, DA_HEAD), 0.1),
        "da_norm_g": 1.0 + nrm((N_C, 2 * DA_HEAD), 0.02),
        "da_w_out": nrm((N_C, D, D), s),
        "final_g": 1.0 + nrm((D,), 0.02),
    }


def reference(x, c, ctx, c_ctx, ada_w, ada_b, norm1_g, norm2_g, ffn_w_in, ffn_conv_w,
              ffn_conv_b, ffn_w_out, ra_mix, ra_w_rkv, ra_w0, ra_w1, ra_w2, ra_a0, ra_a1,
              ra_a2, ra_g1, ra_g2, ra_k_k, ra_k_a, ra_r_k, ra_lnx_g, ra_lnx_b, ra_w_out,
              ml_w_in, ml_b_in, ml_norm_g, ml_w_out, da_w_qkv, da_lambda, da_norm_g,
              da_w_out, final_g):
    for i in range(DEPTH):
        last = i == DEPTH - 1
        kind, j = i % N_MIXERS, i // N_MIXERS
        sh1, sc1, g1, sh2, sc2, g2 = [t[:, None, :] for t in
                                      jnp.split(jax.nn.silu(c) @ ada_w[i] + ada_b[i], 6, axis=-1)]
        csh1, csc1, cg1, csh2, csc2, cg2 = jnp.split(jax.nn.silu(c_ctx) @ ada_w[i] + ada_b[i], 6, axis=-1)
        h_lat = rms_norm(x, norm1_g[i]) * (1.0 + sc1) + sh1
        h_ctx = rms_norm(ctx, norm1_g[i]) * (1.0 + csc1) + csh1
        if kind == 0:
            o_lat, o_ctx = rwkv7_mixer(h_lat, h_ctx, ra_mix[j], ra_w_rkv[j], ra_w0[j], ra_w1[j],
                                       ra_w2[j], ra_a0[j], ra_a1[j], ra_a2[j], ra_g1[j], ra_g2[j],
                                       ra_k_k[j], ra_k_a[j], ra_r_k[j], ra_lnx_g[j], ra_lnx_b[j],
                                       ra_w_out[j], not last)
        elif kind == 1:
            o_lat, o_ctx = mlstm_mixer(h_lat, h_ctx, ml_w_in[j], ml_b_in[j], ml_norm_g[j],
                                       ml_w_out[j], not last)
        else:
            lambda_init = 0.8 - 0.6 * math.exp(-0.3 * i)
            o_lat, o_ctx = diff_attention_mixer(h_lat, h_ctx, da_w_qkv[j], da_lambda[j], da_norm_g[j],
                                                da_w_out[j], lambda_init, not last)
        x = x + g1 * o_lat
        x = x + g2 * conv_ffn(rms_norm(x, norm2_g[i]) * (1.0 + sc2) + sh2,
                              ffn_w_in[i], ffn_conv_w[i], ffn_conv_b[i], ffn_w_out[i])
        if not last:
            ctx = ctx + cg1 * o_ctx
            ctx = ctx + cg2 * conv_ffn(rms_norm(ctx, norm2_g[i]) * (1.0 + csc2) + csh2,
                                       ffn_w_in[i], ffn_conv_w[i], ffn_conv_b[i], ffn_w_out[i])
    return rms_norm(x, final_g)
```

```cpp
#include <hip/hip_runtime.h>
#include <hip/hip_cooperative_groups.h>
#include <cstdio>
#include <cstdint>
#include <cstring>
namespace cg = cooperative_groups;

#define DI __device__ __forceinline__
#define XCD_FOR(t, n) for (int per_ = ((n) + 7) >> 3, i_ = blockIdx.x >> 3, t = (int)(blockIdx.x & 7) * per_ + i_; i_ < per_ && t < (n); i_ += (int)(gridDim.x >> 3), t += (int)(gridDim.x >> 3))
typedef unsigned short bf16_t;
typedef _Float16 f16_t;
typedef short bf16x8 __attribute__((ext_vector_type(8)));
typedef float f32x16 __attribute__((ext_vector_type(16)));
typedef float f32x4 __attribute__((ext_vector_type(4)));
typedef _Float16 f16x4 __attribute__((ext_vector_type(4)));

constexpr int T_ALL = 16896, T_LAT = 16384, DM = 1024, FF = 2816;
constexpr size_t MiB = 1ull << 20;
constexpr size_t OFF_XR = 0, OFF_WB = 66 * MiB, OFF_MISC = 93 * MiB, OFF_ACT = 94 * MiB;
constexpr int SMEM_BYTES = 73728;
constexpr size_t MISC_CNT = 512 * 1024;
constexpr int NPH = 43;

constexpr size_t W_FIN = 0, W_FOUT = 5632ull * 1024, W_MIX = W_FOUT + 1024ull * 2816;
constexpr size_t M1 = 1048576;
constexpr size_t RW_RKV = W_MIX, RW_OUT = W_MIX + 3 * M1, RW_W1C = W_MIX + 4 * M1, RW_A1C = RW_W1C + 131072, RW_G1 = RW_W1C + 262144,
                 RW_W2 = RW_W1C + 524288, RW_A2 = RW_W1C + 655360, RW_G2 = RW_W1C + 786432;
constexpr size_t ML_WIN = W_MIX, ML_WG = W_MIX + 3 * M1, ML_WO = ML_WG + 131072;
constexpr size_t DA_QKV = W_MIX, DA_WO = W_MIX + 3 * M1;

struct Params {
  const float* in[37];
  float* out;
  unsigned char* ws;
  int ph_lo, ph_hi;
};
DI int tidx() { int t = threadIdx.x; asm volatile("" : "+v"(t)); return t; }
DI unsigned char* wsp(const Params& p) { size_t z = 0; asm volatile("" : "+s"(z)); return p.ws + z; }
enum { I_X = 0, I_C, I_CTX, I_CCTX, I_ADAW, I_ADAB, I_N1G, I_N2G, I_FWIN, I_FCW, I_FCB, I_FWOUT, I_RMIX, I_RWRKV, I_RW0, I_RW1, I_RW2, I_RA0, I_RA1,
       I_RA2, I_RG1, I_RG2, I_RKK, I_RKA, I_RRK, I_RLNG, I_RLNB, I_RWOUT, I_MWIN, I_MBIN, I_MNG, I_MWOUT, I_DQKV, I_DLAM, I_DNG, I_DWOUT, I_FING };

DI unsigned f2bf(float f) { unsigned u = __float_as_uint(f); return (u + 0x7fffu + ((u >> 16) & 1u)) >> 16; }
DI float bf2f(unsigned b) { return __uint_as_float(b << 16); }
typedef __bf16 hbf16x2 __attribute__((ext_vector_type(2)));
typedef float hf32x2 __attribute__((ext_vector_type(2)));
DI unsigned pk2(float lo, float hi) { hf32x2 v = {lo, hi}; hbf16x2 b = __builtin_convertvector(v, hbf16x2); return __builtin_bit_cast(unsigned, b); }
DI float bflo(unsigned u) { return __uint_as_float(u << 16); }
DI float bfhi(unsigned u) { return __uint_as_float(u & 0xffff0000u); }
template <int CTRL> DI float dpp_f0(float v) { return __int_as_float(__builtin_amdgcn_update_dpp(0, __float_as_int(v), CTRL, 0xF, 0xF, true)); }
DI float wave_sum(float v) {
  v += dpp_f0<0xB1>(v); v += dpp_f0<0x4E>(v); v += dpp_f0<0x141>(v); v += dpp_f0<0x140>(v);
  v += __shfl_xor(v, 16);
  v += __shfl_xor(v, 32);
  return v;
}
template <int CTRL> DI float dpp_f(float v) { return __int_as_float(__builtin_amdgcn_update_dpp(0, __float_as_int(v), CTRL, 0xF, 0xF, true)); }
DI float allreduce16(float v) {
  v += dpp_f<0xB1>(v);
  v += dpp_f<0x4E>(v);
  v += dpp_f<0x141>(v);
  v += dpp_f<0x140>(v);
  return v;
}
DI float tanh_fast(float x) { return 1.f - 2.f * __builtin_amdgcn_rcpf(1.f + __expf(2.f * x)); }
DI float sigmoidf_(float x) { return __builtin_amdgcn_rcpf(1.f + __expf(-x)); }
DI int modset_of(int row) { return row < T_LAT ? (row >> 13) : 2; }
DI f32x16 mfma32(bf16x8 a, bf16x8 b, f32x16 c) { return __builtin_amdgcn_mfma_f32_32x32x16_bf16(a, b, c, 0, 0, 0); }
DI bf16x8 pack8(const f32x16& x, int s) {
  uint4 u;
  if (s == 0) { u.x = pk2(x[0], x[1]); u.y = pk2(x[2], x[3]); u.z = pk2(x[4], x[5]); u.w = pk2(x[6], x[7]); }
  else { u.x = pk2(x[8], x[9]); u.y = pk2(x[10], x[11]); u.z = pk2(x[12], x[13]); u.w = pk2(x[14], x[15]); }
  return __builtin_bit_cast(bf16x8, u);
}
DI int perm16(int w) { return 8 * ((w >> 2) & 1) + 4 * (w >> 3) + (w & 3); }

DI int swz_tm(int t, int tilesN) { const int per_g = 8 * tilesN, g = t / per_g, idx = t - g * per_g, rows = (132 - 8 * g) < 8 ? (132 - 8 * g) : 8; return 8 * g + idx % rows; }
DI int swz_tn(int t, int tilesN) { const int per_g = 8 * tilesN, g = t / per_g, idx = t - g * per_g, rows = (132 - 8 * g) < 8 ? (132 - 8 * g) : 8; return idx / rows; }
constexpr int G_ROWB = 144, G_OPB = 128 * G_ROWB, G_STAGE = 2 * G_OPB;

template <class Epi>
DI void gemm_epilogue(unsigned char* lds, f32x16 (&acc)[2][2], int tm, int tn, const Epi& epi) {
  const int tid = tidx(), lane = tid & 63, wid = tid >> 6;
  const int wm = wid & 1, wn = wid >> 1, r32 = lane & 31, hh = lane >> 5;
  const int m0 = tm * 128, n0 = tn * 128;
  if constexpr (Epi::kBatch == 2) {
    const bool tr = epi.trans(n0);
#pragma unroll
    for (int mi = 0; mi < 2; ++mi) {
      const int rl = 64 * wm + 32 * mi + r32;
#pragma unroll
      for (int ig = 0; ig < 4; ++ig) {
        const int cl = 64 * wn + 8 * ig + 4 * hh;
        float4 lo = make_float4(acc[0][mi][4 * ig], acc[0][mi][4 * ig + 1], acc[0][mi][4 * ig + 2], acc[0][mi][4 * ig + 3]);
        float4 hi = make_float4(acc[1][mi][4 * ig], acc[1][mi][4 * ig + 1], acc[1][mi][4 * ig + 2], acc[1][mi][4 * ig + 3]);
        epi.xf(m0 + rl, n0 + cl, lo, hi);
        uint2 ulo, uhi;
        if (Epi::kF16) {
          f16x4 a, b; a[0] = (f16_t)lo.x; a[1] = (f16_t)lo.y; a[2] = (f16_t)lo.z; a[3] = (f16_t)lo.w; b[0] = (f16_t)hi.x; b[1] = (f16_t)hi.y; b[2] = (f16_t)hi.z; b[3] = (f16_t)hi.w;
          ulo = __builtin_bit_cast(uint2, a); uhi = __builtin_bit_cast(uint2, b);
        } else { ulo.x = pk2(lo.x, lo.y); ulo.y = pk2(lo.z, lo.w); uhi.x = pk2(hi.x, hi.y); uhi.y = pk2(hi.z, hi.w); }
        if (!tr) {
          *(uint2*)(lds + rl * 272 + cl * 2) = ulo;
          *(uint2*)(lds + rl * 272 + (cl + 32) * 2) = uhi;
        } else {
          const int rp = ((rl & ~15) | perm16(rl & 15)) * 2;
          unsigned short* q0 = (unsigned short*)(lds + cl * 272 + rp); unsigned short* q1 = (unsigned short*)(lds + (cl + 32) * 272 + rp);
          q0[0] = (unsigned short)(ulo.x & 0xffff); q0[136] = (unsigned short)(ulo.x >> 16); q0[272] = (unsigned short)(ulo.y & 0xffff); q0[408] = (unsigned short)(ulo.y >> 16);
          q1[0] = (unsigned short)(uhi.x & 0xffff); q1[136] = (unsigned short)(uhi.x >> 16); q1[272] = (unsigned short)(uhi.y & 0xffff); q1[408] = (unsigned short)(uhi.y >> 16);
        }
      }
    }
    __syncthreads();
    const int nch = epi.valid16(n0);
#pragma unroll
    for (int i = 0; i < 8; ++i) {
      const int c = tid + 256 * i, row = c >> 4, cc = c & 15;
      if (cc < nch) {
        uint4 v = *(const uint4*)(lds + row * 272 + cc * 16);
        v = epi.post(m0, n0, row, cc, v);
        *(uint4*)(epi.rowptr(m0, n0, row) + cc * 8) = v;
      }
    }
    __syncthreads();
  } else if constexpr (Epi::kBatch == 3) {
#pragma unroll
    for (int mi = 0; mi < 2; ++mi) {
      const int rl = 64 * wm + 32 * mi + r32;
#pragma unroll
      for (int ig = 0; ig < 4; ++ig) {
        const int cl = 64 * wn + 8 * ig + 4 * hh;
        *(float4*)(lds + rl * 528 + cl * 4) = make_float4(acc[0][mi][4 * ig], acc[0][mi][4 * ig + 1], acc[0][mi][4 * ig + 2], acc[0][mi][4 * ig + 3]);
        *(float4*)(lds + rl * 528 + (cl + 32) * 4) = make_float4(acc[1][mi][4 * ig], acc[1][mi][4 * ig + 1], acc[1][mi][4 * ig + 2], acc[1][mi][4 * ig + 3]);
      }
    }
    __syncthreads();
#pragma unroll
    for (int h2 = 0; h2 < 2; ++h2) {
      float4 x[8], g[8];
#pragma unroll
      for (int i = 0; i < 8; ++i) {
        const int c = tid + 256 * (8 * h2 + i), row = c >> 5, cc = c & 31, m = m0 + row;
        x[i] = *(const float4*)(epi.xr + (size_t)m * DM + n0 + cc * 4);
        g[i] = *(const float4*)(epi.gate + modset_of(m) * 6144 + n0 + cc * 4);
      }
#pragma unroll
      for (int i = 0; i < 8; ++i) {
        const int c = tid + 256 * (8 * h2 + i), row = c >> 5, cc = c & 31, m = m0 + row;
        const float4 a = *(const float4*)(lds + row * 528 + cc * 16);
        float4 o = x[i];
        o.x += g[i].x * a.x; o.y += g[i].y * a.y; o.z += g[i].z * a.z; o.w += g[i].w * a.w;
        *(float4*)(epi.xr + (size_t)m * DM + n0 + cc * 4) = o;
      }
    }
    __syncthreads();
  } else {
#pragma unroll
    for (int mi = 0; mi < 2; ++mi) {
      const int m = m0 + 64 * wm + 32 * mi + r32;
#pragma unroll
      for (int ig = 0; ig < 4; ++ig) {
        const int n = n0 + 64 * wn + 8 * ig + 4 * hh;
        float4 lo = make_float4(acc[0][mi][4 * ig], acc[0][mi][4 * ig + 1], acc[0][mi][4 * ig + 2], acc[0][mi][4 * ig + 3]);
        float4 hi = make_float4(acc[1][mi][4 * ig], acc[1][mi][4 * ig + 1], acc[1][mi][4 * ig + 2], acc[1][mi][4 * ig + 3]);
        epi(m, n, lo, hi);
      }
    }
  }
}

template <class Epi>
DI void gemm_tile_p2(unsigned char* lds, const bf16_t* __restrict__ A, int lda, const bf16_t* __restrict__ Bt, int ldb, int K, int tm, int tn, const Epi& epi) {
  const int tid = tidx(), lane = tid & 63, wid = tid >> 6;
  const int wm = wid & 1, wn = wid >> 1, r32 = lane & 31, hh = lane >> 5;
  const int lrow = tid >> 3, kc = tid & 7;
  const int m0 = tm * 128, n0 = tn * 128, nt = K >> 6;
  f32x16 acc[2][2];
#pragma unroll
  for (int a = 0; a < 2; ++a)
#pragma unroll
    for (int b = 0; b < 2; ++b)
#pragma unroll
      for (int i = 0; i < 16; ++i) acc[a][b][i] = 0.f;
  uint4 pa0, pa1, pa2, pa3, pb0, pb1, pb2, pb3, qa0, qa1, qa2, qa3, qb0, qb1, qb2, qb3;
  const bf16_t* Ap = A + (size_t)(m0 + lrow) * lda + kc * 8;
  const bf16_t* Bp = Bt + (size_t)(n0 + lrow) * ldb + kc * 8;
  const size_t a32 = (size_t)32 * lda, b32 = (size_t)32 * ldb;
#define P2_GLOAD(kt_, S) do { const int ko_ = (kt_) * 64; \
    S##a0 = *(const uint4*)(Ap + ko_); S##a1 = *(const uint4*)(Ap + a32 + ko_); S##a2 = *(const uint4*)(Ap + 2 * a32 + ko_); S##a3 = *(const uint4*)(Ap + 3 * a32 + ko_); \
    S##b0 = *(const uint4*)(Bp + ko_); S##b1 = *(const uint4*)(Bp + b32 + ko_); S##b2 = *(const uint4*)(Bp + 2 * b32 + ko_); S##b3 = *(const uint4*)(Bp + 3 * b32 + ko_); } while (0)
#define P2_LWRITE(buf_, S) do { unsigned char* base_ = lds + (buf_) * G_STAGE + lrow * G_ROWB + kc * 16; \
    *(uint4*)(base_) = S##a0; *(uint4*)(base_ + 32 * G_ROWB) = S##a1; *(uint4*)(base_ + 64 * G_ROWB) = S##a2; *(uint4*)(base_ + 96 * G_ROWB) = S##a3; \
    *(uint4*)(base_ + G_OPB) = S##b0; *(uint4*)(base_ + G_OPB + 32 * G_ROWB) = S##b1; *(uint4*)(base_ + G_OPB + 64 * G_ROWB) = S##b2; *(uint4*)(base_ + G_OPB + 96 * G_ROWB) = S##b3; } while (0)
#define P2_LDF(ks_, S) do { S##a0 = *(const bf16x8*)(bA + (ks_) * 32); S##a1 = *(const bf16x8*)(bA + 32 * G_ROWB + (ks_) * 32); \
    S##b0 = *(const bf16x8*)(bB + (ks_) * 32); S##b1 = *(const bf16x8*)(bB + 32 * G_ROWB + (ks_) * 32); } while (0)
#define P2_MMA(S) do { acc[0][0] = mfma32(S##b0, S##a0, acc[0][0]); acc[0][1] = mfma32(S##b0, S##a1, acc[0][1]); \
    acc[1][0] = mfma32(S##b1, S##a0, acc[1][0]); acc[1][1] = mfma32(S##b1, S##a1, acc[1][1]); } while (0)
#define P2_COMPUTE(buf_) do { \
    const unsigned char* bA = lds + (buf_) * G_STAGE + (64 * wm + r32) * G_ROWB + hh * 16; \
    const unsigned char* bB = lds + (buf_) * G_STAGE + G_OPB + (64 * wn + r32) * G_ROWB + hh * 16; \
    bf16x8 fxa0, fxa1, fxb0, fxb1, fya0, fya1, fyb0, fyb1; \
    P2_LDF(0, fx); P2_LDF(1, fy); __builtin_amdgcn_sched_barrier(0); \
    P2_MMA(fx); __builtin_amdgcn_sched_barrier(0); P2_LDF(2, fx); __builtin_amdgcn_sched_barrier(0); \
    P2_MMA(fy); __builtin_amdgcn_sched_barrier(0); P2_LDF(3, fy); __builtin_amdgcn_sched_barrier(0); \
    P2_MMA(fx); P2_MMA(fy); __builtin_amdgcn_sched_barrier(0); } while (0)
  P2_GLOAD(0, p);
  P2_GLOAD(1, q);
  P2_LWRITE(0, p);
  __syncthreads();
#pragma unroll 1
  for (int kt = 0; kt < nt; kt += 2) {
    { const int k2 = (kt + 2 < nt) ? kt + 2 : nt - 1; P2_GLOAD(k2, p); }
    P2_COMPUTE(0);
    P2_LWRITE(1, q);
    __syncthreads();
    { const int k3 = (kt + 3 < nt) ? kt + 3 : nt - 1; P2_GLOAD(k3, q); }
    P2_COMPUTE(1);
    P2_LWRITE(0, p);
    __syncthreads();
  }
  gemm_epilogue(lds, acc, tm, tn, epi);
}


template <class Epi>
DI void gemm_tile_big(unsigned char* lds, const bf16_t* __restrict__ A, int lda, const bf16_t* __restrict__ Bt, int ldb, int K, int tm, int tn, const Epi& epi) {
  const int tid = tidx(), lane = tid & 63, wid = tid >> 6;
  const int wm = wid & 1, wn = wid >> 1, r32 = lane & 31, hh = lane >> 5;
  const int lrow = tid >> 3, kc = tid & 7;
  const int m0 = tm * 256, n0 = tn * 128, nt = K >> 6;
  constexpr int BOFF = 256 * G_ROWB;
  f32x16 acc[2][4];
#pragma unroll
  for (int a = 0; a < 2; ++a)
#pragma unroll
    for (int b = 0; b < 4; ++b)
#pragma unroll
      for (int i = 0; i < 16; ++i) acc[a][b][i] = 0.f;
  uint4 a0, a1, a2, a3, a4, a5, a6, a7, b0, b1, b2, b3;
  const bf16_t* Ap = A + (size_t)(m0 + lrow) * lda + kc * 8;
  const bf16_t* Bp = Bt + (size_t)(n0 + lrow) * ldb + kc * 8;
  const size_t a32 = (size_t)32 * lda, b32 = (size_t)32 * ldb;
#define B_GLOAD(kt_) do { const int ko_ = (kt_) * 64; \
    a0 = *(const uint4*)(Ap + ko_); a1 = *(const uint4*)(Ap + a32 + ko_); a2 = *(const uint4*)(Ap + 2 * a32 + ko_); a3 = *(const uint4*)(Ap + 3 * a32 + ko_); \
    a4 = *(const uint4*)(Ap + 4 * a32 + ko_); a5 = *(const uint4*)(Ap + 5 * a32 + ko_); a6 = *(const uint4*)(Ap + 6 * a32 + ko_); a7 = *(const uint4*)(Ap + 7 * a32 + ko_); \
    b0 = *(const uint4*)(Bp + ko_); b1 = *(const uint4*)(Bp + b32 + ko_); b2 = *(const uint4*)(Bp + 2 * b32 + ko_); b3 = *(const uint4*)(Bp + 3 * b32 + ko_); } while (0)
#define B_LWRITE() do { unsigned char* base_ = lds + lrow * G_ROWB + kc * 16; \
    *(uint4*)(base_) = a0; *(uint4*)(base_ + 32 * G_ROWB) = a1; *(uint4*)(base_ + 64 * G_ROWB) = a2; *(uint4*)(base_ + 96 * G_ROWB) = a3; \
    *(uint4*)(base_ + 128 * G_ROWB) = a4; *(uint4*)(base_ + 160 * G_ROWB) = a5; *(uint4*)(base_ + 192 * G_ROWB) = a6; *(uint4*)(base_ + 224 * G_ROWB) = a7; \
    *(uint4*)(base_ + BOFF) = b0; *(uint4*)(base_ + BOFF + 32 * G_ROWB) = b1; *(uint4*)(base_ + BOFF + 64 * G_ROWB) = b2; *(uint4*)(base_ + BOFF + 96 * G_ROWB) = b3; } while (0)
  B_GLOAD(0);
  B_LWRITE();
  __syncthreads();
  const unsigned char* bA = lds + (128 * wm + r32) * G_ROWB + hh * 16;
  const unsigned char* bB = lds + BOFF + (64 * wn + r32) * G_ROWB + hh * 16;
#define B_COMPUTE() do { \
    _Pragma("unroll") for (int ks = 0; ks < 4; ++ks) { \
      const bf16x8 f0 = *(const bf16x8*)(bB + ks * 32), f1 = *(const bf16x8*)(bB + 32 * G_ROWB + ks * 32); \
      _Pragma("unroll") for (int mi = 0; mi < 4; ++mi) { \
        const bf16x8 af = *(const bf16x8*)(bA + mi * 32 * G_ROWB + ks * 32); \
        acc[0][mi] = mfma32(f0, af, acc[0][mi]); acc[1][mi] = mfma32(f1, af, acc[1][mi]); } } } while (0)
#pragma unroll 1
  for (int kt = 0; kt + 1 < nt; ++kt) {
    B_GLOAD(kt + 1);
    B_COMPUTE();
    __syncthreads();
    B_LWRITE();
    __syncthreads();
  }
  B_COMPUTE();
  __syncthreads();
  if constexpr (Epi::kBatch == 2) {
    const bool tr = epi.trans(n0);
#pragma unroll
    for (int mi = 0; mi < 4; ++mi) {
      const int rl = 128 * wm + 32 * mi + r32;
#pragma unroll
      for (int ig = 0; ig < 4; ++ig) {
        const int cl = 64 * wn + 8 * ig + 4 * hh;
        float4 lo = make_float4(acc[0][mi][4 * ig], acc[0][mi][4 * ig + 1], acc[0][mi][4 * ig + 2], acc[0][mi][4 * ig + 3]);
        float4 hi = make_float4(acc[1][mi][4 * ig], acc[1][mi][4 * ig + 1], acc[1][mi][4 * ig + 2], acc[1][mi][4 * ig + 3]);
        epi.xf(m0 + rl, n0 + cl, lo, hi);
        uint2 ulo, uhi;
        if (Epi::kF16) {
          f16x4 a, b; a[0] = (f16_t)lo.x; a[1] = (f16_t)lo.y; a[2] = (f16_t)lo.z; a[3] = (f16_t)lo.w; b[0] = (f16_t)hi.x; b[1] = (f16_t)hi.y; b[2] = (f16_t)hi.z; b[3] = (f16_t)hi.w;
          ulo = __builtin_bit_cast(uint2, a); uhi = __builtin_bit_cast(uint2, b);
        } else { ulo.x = pk2(lo.x, lo.y); ulo.y = pk2(lo.z, lo.w); uhi.x = pk2(hi.x, hi.y); uhi.y = pk2(hi.z, hi.w); }
        if (!tr) {
          *(uint2*)(lds + rl * 272 + cl * 2) = ulo;
          *(uint2*)(lds + rl * 272 + (cl + 32) * 2) = uhi;
        } else {
          const int rp = ((rl & ~15) | perm16(rl & 15)) * 2;
          unsigned short* q0 = (unsigned short*)(lds + cl * 528 + rp); unsigned short* q1 = (unsigned short*)(lds + (cl + 32) * 528 + rp);
          q0[0] = (unsigned short)(ulo.x & 0xffff); q0[264] = (unsigned short)(ulo.x >> 16); q0[528] = (unsigned short)(ulo.y & 0xffff); q0[792] = (unsigned short)(ulo.y >> 16);
          q1[0] = (unsigned short)(uhi.x & 0xffff); q1[264] = (unsigned short)(uhi.x >> 16); q1[528] = (unsigned short)(uhi.y & 0xffff); q1[792] = (unsigned short)(uhi.y >> 16);
        }
      }
    }
    __syncthreads();
    if (!tr) {
      const int nch = epi.valid16(n0);
#pragma unroll
      for (int i = 0; i < 16; ++i) {
        const int c = tid + 256 * i, row = c >> 4, cc = c & 15;
        if (cc < nch) {
          uint4 v = *(const uint4*)(lds + row * 272 + cc * 16);
          v = epi.post(m0, n0, row, cc, v);
          *(uint4*)(epi.rowptr(m0, n0, row) + cc * 8) = v;
        }
      }
    } else {
#pragma unroll
      for (int i = 0; i < 16; ++i) {
        const int c = tid + 256 * i, row = c >> 5, cc = c & 31;
        *(uint4*)(epi.rowptr(m0, n0, row) + cc * 8) = *(const uint4*)(lds + row * 528 + cc * 16);
      }
    }
    __syncthreads();
  } else {
#pragma unroll
    for (int hf = 0; hf < 2; ++hf) {
      if (wm == hf) {
#pragma unroll
        for (int mi = 0; mi < 4; ++mi) {
          const int rl = 32 * mi + r32;
#pragma unroll
          for (int ig = 0; ig < 4; ++ig) {
            const int cl = 64 * wn + 8 * ig + 4 * hh;
            *(float4*)(lds + rl * 528 + cl * 4) = make_float4(acc[0][mi][4 * ig], acc[0][mi][4 * ig + 1], acc[0][mi][4 * ig + 2], acc[0][mi][4 * ig + 3]);
            *(float4*)(lds + rl * 528 + (cl + 32) * 4) = make_float4(acc[1][mi][4 * ig], acc[1][mi][4 * ig + 1], acc[1][mi][4 * ig + 2], acc[1][mi][4 * ig + 3]);
          }
        }
      }
      __syncthreads();
#pragma unroll
      for (int h2 = 0; h2 < 2; ++h2) {
        float4 x[8], g[8];
#pragma unroll
        for (int i = 0; i < 8; ++i) {
          const int c = tid + 256 * (8 * h2 + i), row = c >> 5, cc = c & 31, m = m0 + 128 * hf + row;
          x[i] = *(const float4*)(epi.xr + (size_t)m * DM + n0 + cc * 4);
          g[i] = *(const float4*)(epi.gate + modset_of(m) * 6144 + n0 + cc * 4);
        }
#pragma unroll
        for (int i = 0; i < 8; ++i) {
          const int c = tid + 256 * (8 * h2 + i), row = c >> 5, cc = c & 31, m = m0 + 128 * hf + row;
          const float4 a = *(const float4*)(lds + row * 528 + cc * 16);
          float4 o = x[i];
          o.x += g[i].x * a.x; o.y += g[i].y * a.y; o.z += g[i].z * a.z; o.w += g[i].w * a.w;
          *(float4*)(epi.xr + (size_t)m * DM + n0 + cc * 4) = o;
        }
      }
      __syncthreads();
    }
  }
}

template <bool MIX, class Epi>
DI void gemm_tile(unsigned char* lds, const bf16_t* __restrict__ A, const bf16_t* __restrict__ A2, const float* __restrict__ mix, int lda,
                  const bf16_t* __restrict__ Bt, int ldb, int K, int tm, int tn, const Epi& epi) {
  if (!MIX && ((K >> 6) & 1) == 0) { gemm_tile_p2(lds, A, lda, Bt, ldb, K, tm, tn, epi); return; }
  const int tid = tidx(), lane = tid & 63, wid = tid >> 6;
  const int wm = wid & 1, wn = wid >> 1, r32 = lane & 31, hh = lane >> 5;
  const int lrow = tid >> 3, kc = tid & 7;
  const int m0 = tm * 128, n0 = tn * 128, nt = K >> 6;
  f32x16 acc[2][2];
#pragma unroll
  for (int a = 0; a < 2; ++a)
#pragma unroll
    for (int b = 0; b < 2; ++b)
#pragma unroll
      for (int i = 0; i < 16; ++i) acc[a][b][i] = 0.f;
  uint4 ra0, ra1, ra2, ra3, rb0, rb1, rb2, rb3, rx0, rx1, rx2, rx3;
  float4 mx0, mx1;
  rx0 = rx1 = rx2 = rx3 = make_uint4(0, 0, 0, 0); mx0 = mx1 = make_float4(0.f, 0.f, 0.f, 0.f);
  const bf16_t* Ap = A + (size_t)(m0 + lrow) * lda + kc * 8;
  const bf16_t* A2p = MIX ? (A2 + (size_t)(m0 + lrow) * lda + kc * 8) : nullptr;
  const bf16_t* Bp = Bt + (size_t)(n0 + lrow) * ldb + kc * 8;
  const size_t a32 = (size_t)32 * lda, b32 = (size_t)32 * ldb;
#define G_GLOAD(kt_) do { const int ko_ = (kt_) * 64; \
    ra0 = *(const uint4*)(Ap + ko_); ra1 = *(const uint4*)(Ap + a32 + ko_); ra2 = *(const uint4*)(Ap + 2 * a32 + ko_); ra3 = *(const uint4*)(Ap + 3 * a32 + ko_); \
    if (MIX) { rx0 = *(const uint4*)(A2p + ko_); rx1 = *(const uint4*)(A2p + a32 + ko_); rx2 = *(const uint4*)(A2p + 2 * a32 + ko_); rx3 = *(const uint4*)(A2p + 3 * a32 + ko_); \
               mx0 = *(const float4*)(mix + ko_ + kc * 8); mx1 = *(const float4*)(mix + ko_ + kc * 8 + 4); } \
    rb0 = *(const uint4*)(Bp + ko_); rb1 = *(const uint4*)(Bp + b32 + ko_); rb2 = *(const uint4*)(Bp + 2 * b32 + ko_); rb3 = *(const uint4*)(Bp + 3 * b32 + ko_); } while (0)
#define G_MIXV(v_, x_) do { if (MIX) { \
    v_.x = pk2(bflo(v_.x) + bflo(x_.x) * mx0.x, bfhi(v_.x) + bfhi(x_.x) * mx0.y); v_.y = pk2(bflo(v_.y) + bflo(x_.y) * mx0.z, bfhi(v_.y) + bfhi(x_.y) * mx0.w); \
    v_.z = pk2(bflo(v_.z) + bflo(x_.z) * mx1.x, bfhi(v_.z) + bfhi(x_.z) * mx1.y); v_.w = pk2(bflo(v_.w) + bflo(x_.w) * mx1.z, bfhi(v_.w) + bfhi(x_.w) * mx1.w); } } while (0)
#define G_LWRITE(buf_) do { unsigned char* base_ = lds + (buf_) * G_STAGE + lrow * G_ROWB + kc * 16; \
    G_MIXV(ra0, rx0); G_MIXV(ra1, rx1); G_MIXV(ra2, rx2); G_MIXV(ra3, rx3); \
    *(uint4*)(base_) = ra0; *(uint4*)(base_ + 32 * G_ROWB) = ra1; *(uint4*)(base_ + 64 * G_ROWB) = ra2; *(uint4*)(base_ + 96 * G_ROWB) = ra3; \
    *(uint4*)(base_ + G_OPB) = rb0; *(uint4*)(base_ + G_OPB + 32 * G_ROWB) = rb1; *(uint4*)(base_ + G_OPB + 64 * G_ROWB) = rb2; *(uint4*)(base_ + G_OPB + 96 * G_ROWB) = rb3; } while (0)
  G_GLOAD(0);
  G_LWRITE(0);
  __syncthreads();
#define G_COMPUTE(buf_) do { \
    const unsigned char* bA = lds + (buf_) * G_STAGE + (64 * wm + r32) * G_ROWB + hh * 16; \
    const unsigned char* bB = lds + (buf_) * G_STAGE + G_OPB + (64 * wn + r32) * G_ROWB + hh * 16; \
    _Pragma("unroll") for (int ks = 0; ks < 4; ++ks) { \
      const bf16x8 af0 = *(const bf16x8*)(bA + ks * 32), af1 = *(const bf16x8*)(bA + 32 * G_ROWB + ks * 32); \
      const bf16x8 bf0 = *(const bf16x8*)(bB + ks * 32), bf1 = *(const bf16x8*)(bB + 32 * G_ROWB + ks * 32); \
      acc[0][0] = mfma32(bf0, af0, acc[0][0]); acc[0][1] = mfma32(bf0, af1, acc[0][1]); \
      acc[1][0] = mfma32(bf1, af0, acc[1][0]); acc[1][1] = mfma32(bf1, af1, acc[1][1]); } } while (0)
#pragma unroll 1
  for (int kt = 0; kt + 1 < nt; ++kt) {
    G_GLOAD(kt + 1);
    G_COMPUTE(kt & 1);
    G_LWRITE((kt + 1) & 1);
    __syncthreads();
  }
  G_COMPUTE((nt - 1) & 1);
  __syncthreads();
  gemm_epilogue(lds, acc, tm, tn, epi);
}

DI void st_bf16x4(bf16_t* p, float4 v) { uint2 u; u.x = pk2(v.x, v.y); u.y = pk2(v.z, v.w); *(uint2*)p = u; }
DI void st_f16x4(f16_t* p, float4 v) { f16x4 h; h[0] = (f16_t)v.x; h[1] = (f16_t)v.y; h[2] = (f16_t)v.z; h[3] = (f16_t)v.w; *(f16x4*)p = h; }

struct EpiBf16 { static constexpr int kBatch = 2; static constexpr bool kF16 = false; bf16_t* C; int ldc; int nvalid; int act;
  DI float4 f(float4 v) const {
    if (act == 1) { v.x = tanh_fast(v.x); v.y = tanh_fast(v.y); v.z = tanh_fast(v.z); v.w = tanh_fast(v.w); }
    else if (act == 2) { v.x = sigmoidf_(v.x); v.y = sigmoidf_(v.y); v.z = sigmoidf_(v.z); v.w = sigmoidf_(v.w); }
    return v; }
  DI void xf(int, int, float4& lo, float4& hi) const { lo = f(lo); hi = f(hi); }
  DI bool trans(int) const { return false; }
  DI int valid16(int n0) const { const int r = (nvalid - n0) >> 3; return r > 16 ? 16 : r; }
  DI uint4 post(int, int, int, int, uint4 v) const { return v; }
  DI bf16_t* rowptr(int m0, int n0, int row) const { return C + (size_t)(m0 + row) * ldc + n0; }
  DI void operator()(int, int, float4, float4) const {} };
struct EpiNull { static constexpr int kBatch = 0; DI void operator()(int, int, float4, float4) const {} };
struct EpiF16 { static constexpr int kBatch = 2; static constexpr bool kF16 = true; f16_t* C;
  DI void xf(int, int, float4&, float4&) const {}
  DI bool trans(int) const { return false; }
  DI int valid16(int) const { return 16; }
  DI uint4 post(int, int, int, int, uint4 v) const { return v; }
  DI bf16_t* rowptr(int m0, int n0, int row) const { return (bf16_t*)C + (size_t)(m0 + row) * DM + n0; }
  DI void operator()(int, int, float4, float4) const {} };
struct EpiResid { static constexpr int kBatch = 3; float* xr; const float* gate;
  DI void operator()(int, int, float4, float4) const {} };
struct EpiDecay { static constexpr int kBatch = 2; static constexpr bool kF16 = true; f16_t* C; const float* bias; int mode;
  DI float4 one(int n, float4 v) const {
    const float4 b = *(const float4*)(bias + n); const float sc = mode == 0 ? 0.6065306597126334f : 1.f;
    v.x = sigmoidf_(v.x + b.x) * sc; v.y = sigmoidf_(v.y + b.y) * sc; v.z = sigmoidf_(v.z + b.z) * sc; v.w = sigmoidf_(v.w + b.w) * sc; return v; }
  DI void xf(int, int n, float4& lo, float4& hi) const { lo = one(n, lo); hi = one(n + 32, hi); }
  DI bool trans(int) const { return false; }
  DI int valid16(int) const { return 16; }
  DI uint4 post(int, int, int, int, uint4 v) const { return v; }
  DI bf16_t* rowptr(int m0, int n0, int row) const { return (bf16_t*)C + (size_t)(m0 + row) * DM + n0; }
  DI void operator()(int, int, float4, float4) const {} };
struct EpiMulZ { static constexpr int kBatch = 2; static constexpr bool kF16 = false; bf16_t* Z; const bf16_t* Z0;
  DI void xf(int, int, float4&, float4&) const {}
  DI bool trans(int) const { return false; }
  DI int valid16(int) const { return 16; }
  DI uint4 post(int m0, int n0, int row, int cc, uint4 v) const {
    const uint4 z = *(const uint4*)(Z0 + (size_t)(m0 + row) * DM + n0 + cc * 8);
    v.x = pk2(bflo(v.x) * bflo(z.x), bfhi(v.x) * bfhi(z.x)); v.y = pk2(bflo(v.y) * bflo(z.y), bfhi(v.y) * bfhi(z.y));
    v.z = pk2(bflo(v.z) * bflo(z.z), bfhi(v.z) * bfhi(z.z)); v.w = pk2(bflo(v.w) * bflo(z.w), bfhi(v.w) * bfhi(z.w)); return v; }
  DI bf16_t* rowptr(int m0, int n0, int row) const { return Z + (size_t)(m0 + row) * DM + n0; }
  DI void operator()(int, int, float4, float4) const {} };
struct EpiMlIn { static constexpr int kBatch = 2; static constexpr bool kF16 = false; bf16_t* C; int ldc; const float* bias; float scale; int act;
  DI float4 one(int n, float4 v) const {
    const float4 b = *(const float4*)(bias + n);
    v.x = (v.x + b.x) * scale; v.y = (v.y + b.y) * scale; v.z = (v.z + b.z) * scale; v.w = (v.w + b.w) * scale;
    if (act) { v.x = sigmoidf_(v.x); v.y = sigmoidf_(v.y); v.z = sigmoidf_(v.z); v.w = sigmoidf_(v.w); }
    return v; }
  DI void xf(int, int n, float4& lo, float4& hi) const { lo = one(n, lo); hi = one(n + 32, hi); }
  DI bool trans(int) const { return false; }
  DI int valid16(int) const { return 16; }
  DI uint4 post(int, int, int, int, uint4 v) const { return v; }
  DI bf16_t* rowptr(int m0, int n0, int row) const { return C + (size_t)(m0 + row) * ldc + n0; }
  DI void operator()(int, int, float4, float4) const {} };
DI float logsig(float x) { return fminf(x, 0.f) - log1pf(__expf(-fabsf(x))); }
struct EpiMlGate { static constexpr int kBatch = 0; float* GT; const float* bias;
  DI void operator()(int m, int n, float4 v, float4) const {
    if (n >= 16) return;
    const float4 b = *(const float4*)(bias + n); v.x += b.x; v.y += b.y; v.z += b.z; v.w += b.w;
    if ((n >> 2) & 1) { v.x = logsig(v.x); v.y = logsig(v.y); v.z = logsig(v.z); v.w = logsig(v.w); }
    *(float4*)(GT + (size_t)m * 16 + n) = v; } };
struct EpiDaQkv { static constexpr int kBatch = 2; static constexpr bool kF16 = false; bf16_t *Q, *K, *VT;
  DI void xf(int m, int n, float4& lo, float4& hi) const {
    if (n < 2048 && m < T_LAT) {
      const int t = m & 8191; const float prow = (float)(t >> 6), pcol = (float)(t & 63);
      const int d0 = n & 63;
      float x1[4] = {lo.x, lo.y, lo.z, lo.w}, x2[4] = {hi.x, hi.y, hi.z, hi.w};
#pragma unroll
      for (int e = 0; e < 4; ++e) {
        const int d = d0 + e; const int f = d & 15;
        const float inv = __builtin_amdgcn_exp2f(-(float)f * 0.8304820237218406f);
        const float ang = (d < 16 ? prow : pcol) * inv;
        const float cs = __cosf(ang), sn = __sinf(ang);
        const float a = x1[e], b = x2[e];
        x1[e] = a * cs - b * sn; x2[e] = a * sn + b * cs;
      }
      lo = make_float4(x1[0], x1[1], x1[2], x1[3]); hi = make_float4(x2[0], x2[1], x2[2], x2[3]);
    }
  }
  DI bool trans(int n0) const { return n0 >= 2048; }
  DI int valid16(int) const { return 16; }
  DI uint4 post(int, int, int, int, uint4 v) const { return v; }
  DI bf16_t* rowptr(int m0, int n0, int row) const {
    if (n0 < 2048) return (n0 < 1024 ? Q : K) + (size_t)(m0 + row) * DM + (n0 & 1023);
    int b, key;
    if (m0 < T_LAT) { b = m0 >> 13; key = m0 & 8191; } else { b = (m0 - T_LAT) >> 8; key = 8192 + ((m0 - T_LAT) & 255); }
    const int head = (n0 - 2048) >> 7;
    return VT + ((size_t)(b * 8 + head) * 128 + row) * 8448 + key;
  }
  DI void operator()(int, int, float4, float4) const {} };

struct Job { const float* src; bf16_t* dst; int K, N, lds, Kp, Np; };
DI Job mkjob(const float* s, bf16_t* d, int K, int N, int lds, int Kp, int Np) { Job j; j.src = s; j.dst = d; j.K = K; j.N = N; j.lds = lds; j.Kp = Kp; j.Np = Np; return j; }
DI int layer_jobs(const Params& p, int layer, int idx, Job& jb) {
  bf16_t* wb = (bf16_t*)(wsp(p) + OFF_WB);
  const int kind = layer % 3, j = layer / 3;
  if (idx == 0) { jb = mkjob(p.in[I_FWIN] + (size_t)layer * 1024 * 5632, wb + W_FIN, 1024, 5632, 5632, 1024, 5632); }
  else if (idx == 1) { jb = mkjob(p.in[I_FWOUT] + (size_t)layer * 2816 * 1024, wb + W_FOUT, 2816, 1024, 1024, 2816, 1024); }
  else if (kind == 0) {
    const int q = idx - 2;
    if (q < 3) jb = mkjob(p.in[I_RWRKV] + (size_t)(j * 3 + q) * M1, wb + RW_RKV + q * M1, 1024, 1024, 1024, 1024, 1024);
    else if (q == 3) jb = mkjob(p.in[I_RWOUT] + (size_t)j * M1, wb + RW_OUT, 1024, 1024, 1024, 1024, 1024);
    else if (q < 6) jb = mkjob(p.in[I_RW1] + (size_t)(j * 2 + (q - 4)) * 65536, wb + RW_W1C + (q - 4) * 65536, 1024, 64, 64, 1024, 64);
    else if (q < 8) jb = mkjob(p.in[I_RA1] + (size_t)(j * 2 + (q - 6)) * 65536, wb + RW_A1C + (q - 6) * 65536, 1024, 64, 64, 1024, 64);
    else if (q == 8) jb = mkjob(p.in[I_RG1] + (size_t)j * 163840, wb + RW_G1, 1024, 160, 160, 1024, 256);
    else if (q < 11) jb = mkjob(p.in[I_RW2] + (size_t)(j * 2 + (q - 9)) * 65536, wb + RW_W2 + (q - 9) * 65536, 64, 1024, 1024, 64, 1024);
    else if (q < 13) jb = mkjob(p.in[I_RA2] + (size_t)(j * 2 + (q - 11)) * 65536, wb + RW_A2 + (q - 11) * 65536, 64, 1024, 1024, 64, 1024);
    else jb = mkjob(p.in[I_RG2] + (size_t)j * 163840, wb + RW_G2, 160, 1024, 1024, 192, 1024);
    return 16;
  } else if (kind == 1) {
    const int q = idx - 2;
    if (q == 0) jb = mkjob(p.in[I_MWIN] + (size_t)j * 1024 * 3088, wb + ML_WIN, 1024, 3072, 3088, 1024, 3072);
    else if (q == 1) jb = mkjob(p.in[I_MWIN] + (size_t)j * 1024 * 3088 + 3072, wb + ML_WG, 1024, 16, 3088, 1024, 128);
    else jb = mkjob(p.in[I_MWOUT] + (size_t)j * M1, wb + ML_WO, 1024, 1024, 1024, 1024, 1024);
    return 5;
  } else {
    const int q = idx - 2;
    if (q == 0) jb = mkjob(p.in[I_DQKV] + (size_t)j * 3 * M1, wb + DA_QKV, 1024, 3072, 3072, 1024, 3072);
    else jb = mkjob(p.in[I_DWOUT] + (size_t)j * M1, wb + DA_WO, 1024, 1024, 1024, 1024, 1024);
    return 4;
  }
  return kind == 0 ? 16 : (kind == 1 ? 5 : 4);
}
DI void convert_weights(const Params& p, int layer, unsigned char* smem, int qlo = 0, int qhi = 99, int* dyn = nullptr) {
  float* tile = (float*)smem;
  const int tid = tidx();
  int* shw = (int*)(smem + SMEM_BYTES - 32);
  Job jb; const int njobs = layer_jobs(p, layer, 0, jb);
  if (qhi > njobs) qhi = njobs;
  int total = 0;
  for (int q = qlo; q < qhi; ++q) { layer_jobs(p, layer, q, jb); total += (jb.Kp >> 6) * (jb.Np >> 6); }
  int item = blockIdx.x;
  if (dyn) { if (tid == 0) shw[0] = atomicAdd(dyn, 1); __syncthreads(); item = shw[0]; }
  while (item < total) {
    int rem = item, q = qlo;
    for (;; ++q) { layer_jobs(p, layer, q, jb); const int c = (jb.Kp >> 6) * (jb.Np >> 6); if (rem < c) break; rem -= c; }
    const int tnn = jb.Np >> 6; const int kt = rem / tnn, ntl = rem % tnn;
    const int k0 = kt * 64, n0 = ntl * 64;
    const int tx = tid & 63, ty = tid >> 6;
    float tv[16];
#pragma unroll
    for (int i = 0; i < 16; ++i) {
      const int kl = 4 * i + ty, k = k0 + kl, n = n0 + tx;
      tv[i] = (k < jb.K && n < jb.N) ? jb.src[(size_t)k * jb.lds + n] : 0.f;
    }
#pragma unroll
    for (int i = 0; i < 16; ++i) tile[(4 * i + ty) * 65 + tx] = tv[i];
    __syncthreads();
    {
      const int nl = tid >> 2, kq = tid & 3;
      uint4 o0, o1;
      const float* tp = tile + (16 * kq) * 65 + nl;
      o0.x = pk2(tp[0], tp[65]); o0.y = pk2(tp[2 * 65], tp[3 * 65]); o0.z = pk2(tp[4 * 65], tp[5 * 65]); o0.w = pk2(tp[6 * 65], tp[7 * 65]);
      o1.x = pk2(tp[8 * 65], tp[9 * 65]); o1.y = pk2(tp[10 * 65], tp[11 * 65]); o1.z = pk2(tp[12 * 65], tp[13 * 65]); o1.w = pk2(tp[14 * 65], tp[15 * 65]);
      bf16_t* d = jb.dst + (size_t)(n0 + nl) * jb.Kp + k0 + 16 * kq;
      *(uint4*)d = o0; *(uint4*)(d + 8) = o1;
    }
    __syncthreads();
    if (dyn) { if (tid == 0) shw[0] = atomicAdd(dyn, 1); __syncthreads(); item = shw[0]; } else item += gridDim.x;
  }
}

DI void norm_row_regs(const float* __restrict__ xrow, const float* __restrict__ g, const float* __restrict__ sh, const float* __restrict__ sc, int lane, float (&v)[16]) {
  float ss = 0.f;
#pragma unroll
  for (int j = 0; j < 4; ++j) {
    const float4 x = *(const float4*)(xrow + 4 * lane + 256 * j);
    v[4 * j] = x.x; v[4 * j + 1] = x.y; v[4 * j + 2] = x.z; v[4 * j + 3] = x.w;
    ss += x.x * x.x + x.y * x.y + x.z * x.z + x.w * x.w;
  }
  ss = wave_sum(ss);
  const float rs = __builtin_amdgcn_rsqf(ss * (1.f / 1024.f) + 1e-6f);
#pragma unroll
  for (int j = 0; j < 4; ++j) {
    const int c = 4 * lane + 256 * j;
    const float4 gg = *(const float4*)(g + c);
    float4 s1 = make_float4(0.f, 0.f, 0.f, 0.f), s0 = make_float4(0.f, 0.f, 0.f, 0.f);
    if (sc) { s1 = *(const float4*)(sc + c); s0 = *(const float4*)(sh + c); }
    v[4 * j] = v[4 * j] * rs * gg.x * (1.f + s1.x) + s0.x;
    v[4 * j + 1] = v[4 * j + 1] * rs * gg.y * (1.f + s1.y) + s0.y;
    v[4 * j + 2] = v[4 * j + 2] * rs * gg.z * (1.f + s1.z) + s0.z;
    v[4 * j + 3] = v[4 * j + 3] * rs * gg.w * (1.f + s1.w) + s0.w;
  }
}
DI void store_row_bf16(bf16_t* orow, int lane, const float (&v)[16]) {
#pragma unroll
  for (int j = 0; j < 4; ++j) { uint2 u; u.x = pk2(v[4 * j], v[4 * j + 1]); u.y = pk2(v[4 * j + 2], v[4 * j + 3]); *(uint2*)(orow + 4 * lane + 256 * j) = u; }
}
DI void norm_load(const float* __restrict__ xrow, int lane, float (&v)[16]) {
#pragma unroll
  for (int j = 0; j < 4; ++j) { const float4 x = *(const float4*)(xrow + 4 * lane + 256 * j); v[4 * j] = x.x; v[4 * j + 1] = x.y; v[4 * j + 2] = x.z; v[4 * j + 3] = x.w; }
}
DI void norm_finish(const float* __restrict__ g, const float* __restrict__ sh, const float* __restrict__ sc, int lane, float (&v)[16]) {
  float ss = 0.f;
#pragma unroll
  for (int i = 0; i < 16; ++i) ss += v[i] * v[i];
  ss = wave_sum(ss);
  const float rs = __builtin_amdgcn_rsqf(ss * (1.f / 1024.f) + 1e-6f);
#pragma unroll
  for (int j = 0; j < 4; ++j) {
    const int c = 4 * lane + 256 * j;
    const float4 gg = *(const float4*)(g + c);
    float4 s1 = make_float4(0.f, 0.f, 0.f, 0.f), s0 = make_float4(0.f, 0.f, 0.f, 0.f);
    if (sc) { s1 = *(const float4*)(sc + c); s0 = *(const float4*)(sh + c); }
    v[4 * j] = v[4 * j] * rs * gg.x * (1.f + s1.x) + s0.x;
    v[4 * j + 1] = v[4 * j + 1] * rs * gg.y * (1.f + s1.y) + s0.y;
    v[4 * j + 2] = v[4 * j + 2] * rs * gg.z * (1.f + s1.z) + s0.z;
    v[4 * j + 3] = v[4 * j + 3] * rs * gg.w * (1.f + s1.w) + s0.w;
  }
}
DI void phase_norm(const Params& p, int layer, int which  , bf16_t* out, int nrows = T_ALL) {
  const float* xr = (const float*)(wsp(p) + OFF_XR);
  const float* mod = (const float*)(wsp(p) + OFF_MISC) + (size_t)layer * 3 * 6144;
  const float* g = p.in[which ? I_N2G : I_N1G] + layer * 1024;
  const int lane = tidx() & 63, wid = tidx() >> 6;
  for (int row = (blockIdx.x * 4 + wid) * 2; row < nrows; row += gridDim.x * 8) {
    const float* ms = mod + modset_of(row) * 6144 + (which ? 3 : 0) * 1024;
    float va[16], vb[16];
    norm_load(xr + (size_t)row * DM, lane, va);
    norm_load(xr + (size_t)(row + 1) * DM, lane, vb);
    norm_finish(g, ms, ms + 1024, lane, va);
    norm_finish(g, ms, ms + 1024, lane, vb);
    store_row_bf16(out + (size_t)row * DM, lane, va);
    store_row_bf16(out + (size_t)(row + 1) * DM, lane, vb);
  }
}
DI void phase_norm_shift(const Params& p, int layer, bf16_t* hb, bf16_t* xxb, const float* mix, bf16_t* xs0, bf16_t* xs1, bf16_t* xs2) {
  const float* xr = (const float*)(wsp(p) + OFF_XR);
  const float* mod = (const float*)(wsp(p) + OFF_MISC) + (size_t)layer * 3 * 6144;
  const float* g = p.in[I_N1G] + layer * 1024;
  const int lane = tidx() & 63, wid = tidx() >> 6;
  float mr[16], mk[16], mv[16];
#pragma unroll
  for (int jq = 0; jq < 4; ++jq) {
    const float4 a = *(const float4*)(mix + 4 * lane + 256 * jq), b = *(const float4*)(mix + 1024 + 4 * lane + 256 * jq), c = *(const float4*)(mix + 2048 + 4 * lane + 256 * jq);
    mr[4 * jq] = a.x; mr[4 * jq + 1] = a.y; mr[4 * jq + 2] = a.z; mr[4 * jq + 3] = a.w;
    mk[4 * jq] = b.x; mk[4 * jq + 1] = b.y; mk[4 * jq + 2] = b.z; mk[4 * jq + 3] = b.w;
    mv[4 * jq] = c.x; mv[4 * jq + 1] = c.y; mv[4 * jq + 2] = c.z; mv[4 * jq + 3] = c.w;
  }
  for (int u = blockIdx.x * 4 + wid; u < T_ALL / 16; u += gridDim.x * 4) {
    const int row0 = u * 16;
    int s0, len;
    if (row0 < T_LAT) { s0 = row0 & ~8191; len = 8192; } else { s0 = T_LAT + ((row0 - T_LAT) & ~255); len = 256; }
    const float* ms = mod + modset_of(row0) * 6144;
    float prev[16], cur[16], nxt[16], raw[16];
    if (row0 > s0) norm_row_regs(xr + (size_t)(row0 - 1) * DM, g, ms, ms + 1024, lane, prev);
    else {
#pragma unroll
      for (int i = 0; i < 16; ++i) prev[i] = 0.f;
    }
    norm_row_regs(xr + (size_t)row0 * DM, g, ms, ms + 1024, lane, cur);
    if (row0 + 1 < s0 + len) norm_load(xr + (size_t)(row0 + 1) * DM, lane, raw);
    for (int i = 0; i < 16; ++i) {
      const int row = row0 + i;
      const bool has1 = row + 1 < s0 + len, has2 = row + 2 < s0 + len && i < 15;
#pragma unroll
      for (int e = 0; e < 16; ++e) nxt[e] = raw[e];
      if (has2) norm_load(xr + (size_t)(row + 2) * DM, lane, raw);
      if (has1) norm_finish(g, ms, ms + 1024, lane, nxt);
      else {
#pragma unroll
        for (int e = 0; e < 16; ++e) nxt[e] = 0.f;
      }
      float xx[16];
#pragma unroll
      for (int e = 0; e < 16; ++e) xx[e] = 0.5f * (prev[e] + nxt[e]) - cur[e];
      store_row_bf16(hb + (size_t)row * DM, lane, cur);
      store_row_bf16(xxb + (size_t)row * DM, lane, xx);
      {
        float t[16];
#pragma unroll
        for (int e = 0; e < 16; ++e) t[e] = cur[e] + xx[e] * mr[e];
        store_row_bf16(xs0 + (size_t)row * DM, lane, t);
#pragma unroll
        for (int e = 0; e < 16; ++e) t[e] = cur[e] + xx[e] * mk[e];
        store_row_bf16(xs1 + (size_t)row * DM, lane, t);
#pragma unroll
        for (int e = 0; e < 16; ++e) t[e] = cur[e] + xx[e] * mv[e];
        store_row_bf16(xs2 + (size_t)row * DM, lane, t);
      }
#pragma unroll
      for (int e = 0; e < 16; ++e) { prev[e] = cur[e]; cur[e] = nxt[e]; }
    }
  }
}

DI void phase0(const Params& p, unsigned char* smem) {
  const int tid = tidx();
  {
    float4* xr = (float4*)(wsp(p) + OFF_XR);
    const float4* x = (const float4*)p.in[I_X]; const float4* cx = (const float4*)p.in[I_CTX];
    const size_t nl = (size_t)T_LAT * DM / 4, na = (size_t)T_ALL * DM / 4;
    for (size_t i = (size_t)blockIdx.x * 256 + tid; i < na; i += (size_t)gridDim.x * 256) xr[i] = i < nl ? x[i] : cx[i - nl];
  }
  if (blockIdx.x == 0) { int* cnt = (int*)(wsp(p) + OFF_MISC + MISC_CNT); for (int i = tid; i < 8192 + 8; i += 256) cnt[i] = 0; }
  float* sv = (float*)smem;
  float* red = sv + 3 * 1024;
  for (int i = tid; i < 3 * 1024; i += 256) {
    const float c = i < 2048 ? p.in[I_C][i] : p.in[I_CCTX][i - 2048];
    sv[i] = c / (1.f + __expf(-c));
  }
  __syncthreads();
  float* mod = (float*)(wsp(p) + OFF_MISC);
  for (int item = blockIdx.x; item < 4 * 96; item += gridDim.x) {
    const int l = item / 96, j0 = (item % 96) * 64, kg = tid >> 6, jj = tid & 63;
    const float* w = p.in[I_ADAW] + (size_t)l * 1024 * 6144 + (size_t)(kg * 256) * 6144 + j0 + jj;
    float a0 = 0.f, a1 = 0.f, a2 = 0.f;
#pragma unroll 32
    for (int k = 0; k < 256; ++k) {
      const float wv = w[(size_t)k * 6144];
      a0 += sv[kg * 256 + k] * wv; a1 += sv[1024 + kg * 256 + k] * wv; a2 += sv[2048 + kg * 256 + k] * wv;
    }
    red[(kg * 3 + 0) * 64 + jj] = a0; red[(kg * 3 + 1) * 64 + jj] = a1; red[(kg * 3 + 2) * 64 + jj] = a2;
    __syncthreads();
    if (tid < 192) {
      const int s = tid >> 6;
      const float r = red[(0 * 3 + s) * 64 + jj] + red[(1 * 3 + s) * 64 + jj] + red[(2 * 3 + s) * 64 + jj] + red[(3 * 3 + s) * 64 + jj];
      mod[((size_t)l * 3 + s) * 6144 + j0 + jj] = r + p.in[I_ADAB][l * 6144 + j0 + jj];
    }
    __syncthreads();
  }
}

DI void phase_ffn_in(const Params& p, unsigned char* smem, const bf16_t* hb, bf16_t* vg, int rowtiles) {
  const bf16_t* wb = (const bf16_t*)(wsp(p) + OFF_WB);
  EpiBf16 epi{vg, 5632, 5632, 0};
  const int rt2 = rowtiles >> 1;
  const int ntile = rt2 * 44;
  XCD_FOR(t, ntile) {
    const int per_g = 4 * 44, g = t / per_g, idx = t - g * per_g, rows = (rt2 - 4 * g) < 4 ? (rt2 - 4 * g) : 4;
    gemm_tile_big(smem, hb, DM, wb + W_FIN, DM, 1024, 4 * g + idx % rows, idx / rows, epi);
  }
}
DI float gelu_tanh(float x) { const float u = 0.7978845608028654f * (x + 0.044715f * x * x * x); return x * __builtin_amdgcn_rcpf(1.f + __expf(-2.f * u)); }
DI void phase_ffn_act(const Params& p, int layer, bf16_t* vg, int nrows) {
  const float* cw = p.in[I_FCW] + (size_t)layer * 3 * FF; const float* cb = p.in[I_FCB] + (size_t)layer * FF;
  const size_t total = (size_t)nrows * (FF / 8);
  for (size_t i = (size_t)blockIdx.x * 256 + tidx(); i < total; i += (size_t)gridDim.x * 256) {
    const int row = (int)(i / (FF / 8)), f0 = (int)(i % (FF / 8)) * 8;
    int s0, len;
    if (row < T_LAT) { s0 = row & ~8191; len = 8192; } else { s0 = T_LAT + ((row - T_LAT) & ~255); len = 256; }
    const bf16_t* vr = vg + (size_t)row * 5632;
    const uint4 val = *(const uint4*)(vr + f0);
    const uint4 gc = *(const uint4*)(vr + FF + f0);
    uint4 gp = make_uint4(0, 0, 0, 0), gn = make_uint4(0, 0, 0, 0);
    if (row > s0) gp = *(const uint4*)(vr - 5632 + FF + f0);
    if (row + 1 < s0 + len) gn = *(const uint4*)(vr + 5632 + FF + f0);
    const unsigned va[4] = {val.x, val.y, val.z, val.w}, ca[4] = {gc.x, gc.y, gc.z, gc.w}, pa[4] = {gp.x, gp.y, gp.z, gp.w}, na[4] = {gn.x, gn.y, gn.z, gn.w};
    const float4 w0a = *(const float4*)(cw + f0), w0b = *(const float4*)(cw + f0 + 4), w1a = *(const float4*)(cw + FF + f0), w1b = *(const float4*)(cw + FF + f0 + 4);
    const float4 w2a = *(const float4*)(cw + 2 * FF + f0), w2b = *(const float4*)(cw + 2 * FF + f0 + 4), cba = *(const float4*)(cb + f0), cbb = *(const float4*)(cb + f0 + 4);
    const float t0[8] = {w0a.x, w0a.y, w0a.z, w0a.w, w0b.x, w0b.y, w0b.z, w0b.w}, t1[8] = {w1a.x, w1a.y, w1a.z, w1a.w, w1b.x, w1b.y, w1b.z, w1b.w};
    const float t2[8] = {w2a.x, w2a.y, w2a.z, w2a.w, w2b.x, w2b.y, w2b.z, w2b.w}, tb[8] = {cba.x, cba.y, cba.z, cba.w, cbb.x, cbb.y, cbb.z, cbb.w};
    unsigned o[4];
#pragma unroll
    for (int e = 0; e < 4; ++e) {
      const float g0 = t0[2 * e] * bflo(pa[e]) + t1[2 * e] * bflo(ca[e]) + t2[2 * e] * bflo(na[e]) + tb[2 * e];
      const float g1 = t0[2 * e + 1] * bfhi(pa[e]) + t1[2 * e + 1] * bfhi(ca[e]) + t2[2 * e + 1] * bfhi(na[e]) + tb[2 * e + 1];
      o[e] = pk2(gelu_tanh(g0) * bflo(va[e]), gelu_tanh(g1) * bfhi(va[e]));
    }
    *(uint4*)(vg + (size_t)row * 5632 + f0) = make_uint4(o[0], o[1], o[2], o[3]);
  }
}
DI void phase_gemm_resid(const Params& p, unsigned char* smem, int layer, const bf16_t* A, int lda, int K, const bf16_t* Wt, int gate_chunk, int rowtiles = 132) {
  EpiResid epi{(float*)(wsp(p) + OFF_XR), (const float*)(wsp(p) + OFF_MISC) + (size_t)layer * 3 * 6144 + gate_chunk * 1024};
  XCD_FOR(t, 512) { const int g = t >> 6, idx = t & 63; gemm_tile_big(smem, A, lda, Wt, K, K, 8 * g + (idx & 7), idx >> 3, epi); }
  if (rowtiles > 128) XCD_FOR(t, 32) gemm_tile<false>(smem, A, nullptr, nullptr, lda, Wt, K, K, 128 + (t & 3), t >> 2, epi);
}

constexpr size_t RA_R = 0, RA_K = 33, RA_V = 66, RA_E0 = 99, RA_E1 = 132, RA_A0 = 165, RA_A1 = 198, RA_HB = 99, RA_XX = 132,
                 RA_Y1 = 231, RA_Z0 = 99, RA_ZB = 132;
constexpr size_t RO_Y0 = 0, RO_LW = 33, RO_LA = 38, RO_LG = 43, RO_CB = 50;
DI unsigned char* outp(const Params& p, size_t mib) { size_t z = 0; asm volatile("" : "+s"(z)); return (unsigned char*)p.out + mib * MiB + z; }
DI unsigned char* actp(const Params& p, size_t mib) { return wsp(p) + OFF_ACT + mib * MiB; }

constexpr size_t RA_XS0 = 165, RA_XS1 = 198, RA_XS2 = 231;
DI void phase_rwkv_proj1(const Params& p, int j, unsigned char* smem) {
  const bf16_t* wb = (const bf16_t*)(wsp(p) + OFF_WB);
  const bf16_t* hb = (const bf16_t*)actp(p, RA_HB); const bf16_t* xx = (const bf16_t*)actp(p, RA_XX);
  const float* mix = p.in[I_RMIX] + (size_t)j * 6 * 1024;
  XCD_FOR(t, 3 * 512) {
    const int q = t >> 9, r = t & 511, g = r >> 6, idx = r & 63;
    EpiF16 epi{(f16_t*)actp(p, RA_R + 33 * q)};
    gemm_tile_big(smem, (const bf16_t*)actp(p, RA_XS0 + 33 * q), DM, wb + RW_RKV + q * M1, DM, 1024, 8 * g + (idx & 7), idx >> 3, epi);
  }
  const int total = 96 + 132 + 132 + 264;
  XCD_FOR(t, total) {
    if (t < 96) {
      const int q = t >> 5, r = t & 31;
      EpiF16 epi{(f16_t*)actp(p, RA_R + 33 * q)};
      gemm_tile<false>(smem, (const bf16_t*)actp(p, RA_XS0 + 33 * q), nullptr, nullptr, DM, wb + RW_RKV + q * M1, DM, 1024, 128 + (r & 3), r >> 2, epi);
    } else if (t < 96 + 132) {
      const int r = t - 96;
      EpiBf16 epi{(bf16_t*)outp(p, RO_LW), 128, 128, 1};
      gemm_tile<true>(smem, hb, xx, mix + 3 * 1024, DM, wb + RW_W1C, DM, 1024, r, 0, epi);
    } else if (t < 96 + 264) {
      const int r = t - 96 - 132;
      EpiBf16 epi{(bf16_t*)outp(p, RO_LA), 128, 128, 0};
      gemm_tile<true>(smem, hb, xx, mix + 4 * 1024, DM, wb + RW_A1C, DM, 1024, r, 0, epi);
    } else {
      const int r = t - 96 - 264;
      EpiBf16 epi{(bf16_t*)outp(p, RO_LG), 192, 192, 2};
      gemm_tile<true>(smem, hb, xx, mix + 5 * 1024, DM, wb + RW_G1, DM, 1024, swz_tm(r, 2), swz_tn(r, 2), epi);
    }
  }
}
DI void phase_rwkv_proj2(const Params& p, int j, unsigned char* smem) {
  const bf16_t* wb = (const bf16_t*)(wsp(p) + OFF_WB);
  auto mkA = [&](int q) -> const bf16_t* { const int d = q & 1; return (const bf16_t*)outp(p, q < 2 ? RO_LW : RO_LA) + d * 64; };
  auto mkB = [&](int q) -> const bf16_t* { const int d = q & 1; return wb + (q < 2 ? RW_W2 : RW_A2) + d * 65536; };
  auto mkE = [&](int q) { const int d = q & 1;
    EpiDecay epi; epi.C = (f16_t*)actp(p, q < 2 ? (d ? RA_E1 : RA_E0) : (d ? RA_A1 : RA_A0)); epi.bias = p.in[q < 2 ? I_RW0 : I_RA0] + (size_t)(j * 2 + d) * 1024; epi.mode = q < 2 ? 0 : 1; return epi; };
  XCD_FOR(t, 4 * 512) { const int q = t >> 9, r = t & 511, g = r >> 6, idx = r & 63; const EpiDecay epi = mkE(q);
    gemm_tile_big(smem, mkA(q), 128, mkB(q), 64, 64, 8 * g + (idx & 7), idx >> 3, epi); }
  XCD_FOR(t, 4 * 32) { const int q = t >> 5, r = t & 31; const EpiDecay epi = mkE(q);
    gemm_tile<false>(smem, mkA(q), nullptr, nullptr, 128, mkB(q), 64, 64, 128 + (r & 3), r >> 2, epi); }
}

constexpr int SC_BUF = 25600;
typedef float f32x2 __attribute__((ext_vector_type(2)));
DI unsigned hw_cu_key() {
  const unsigned xcc = (unsigned)__builtin_amdgcn_s_getreg((3 << 11) | 20) & 0xFu;
  const unsigned cu = ((unsigned)__builtin_amdgcn_s_getreg(63492) >> 8) & 0xFFu;
  return xcc * 256u + cu;
}
DI void phase_rwkv_scan(const Params& p, int j, unsigned char* smem, int cset) {
  const f16_t* RB = (const f16_t*)actp(p, RA_R); const f16_t* KB = (const f16_t*)actp(p, RA_K); const f16_t* VB = (const f16_t*)actp(p, RA_V);
  float* CB = (float*)outp(p, RO_CB);
  int* cuCnt = (int*)(wsp(p) + OFF_MISC + MISC_CNT) + cset * 2048; int* itemCnt = (int*)(wsp(p) + OFF_MISC + MISC_CNT) + 8192 + cset;
  const int tid = tidx(), lane = tid & 63, wv = tid >> 6;
  const int stj = tid >> 4, scg = tid & 15;
  const int g = lane & 15, rl = wv * 4 + (lane >> 4);
  int* shi = (int*)(smem + SMEM_BYTES - 16);
  if (tid == 0) {
    const int k = atomicAdd(cuCnt + hw_cu_key(), 1);
    shi[0] = (k == 0) ? atomicAdd(itemCnt, 1) : 256;
  }
  __syncthreads();
  int item = shi[0];
  while (item < 256) {
    const int hd = item >> 2, rg = item & 3, dir = hd & 1, bh = hd >> 1, b = bh >> 4, h = bh & 15;
    const f16_t* EB = (const f16_t*)actp(p, dir ? RA_E1 : RA_E0); const f16_t* AB = (const f16_t*)actp(p, dir ? RA_A1 : RA_A0);
    bf16_t* YB = dir ? (bf16_t*)actp(p, RA_Y1) : (bf16_t*)outp(p, RO_Y0);
    const int ch = h * 64 + 4 * scg;
    const float4 kk4 = *(const float4*)(p.in[I_RKK] + j * 1024 + ch), ka4 = *(const float4*)(p.in[I_RKA] + j * 1024 + ch),
                 rk4 = *(const float4*)(p.in[I_RRK] + j * 1024 + ch);
    f32x2 Sa = {0.f, 0.f}, Sb = {0.f, 0.f};
    f16x4 pr, pk, pe, pa; f16_t pv;
    auto rowof = [&](int cidx, int jj) -> int {
      int base;
      if (cidx < 16) base = T_LAT + b * 256 + 16 * (dir ? 15 - cidx : cidx);
      else { const int lc = cidx - 16; base = b * 8192 + 16 * (dir ? 511 - lc : lc); }
      return base + (dir ? 15 - jj : jj);
    };
    auto gload = [&](int cidx) {
      const size_t row = (size_t)rowof(cidx, stj);
      pr = *(const f16x4*)(RB + row * DM + ch); pk = *(const f16x4*)(KB + row * DM + ch);
      pe = *(const f16x4*)(EB + row * DM + ch); pa = *(const f16x4*)(AB + row * DM + ch);
      pv = VB[row * DM + h * 64 + 16 * rg + scg];
    };
    auto lwrite = [&](int cidx) {
      float* dat = (float*)(smem + (cidx & 1) * SC_BUF);
      const float kf[4] = {(float)pk[0], (float)pk[1], (float)pk[2], (float)pk[3]};
      const float af[4] = {(float)pa[0], (float)pa[1], (float)pa[2], (float)pa[3]};
      const float rf[4] = {(float)pr[0], (float)pr[1], (float)pr[2], (float)pr[3]};
      const float kkc[4] = {kk4.x, kk4.y, kk4.z, kk4.w}, kac[4] = {ka4.x, ka4.y, ka4.z, ka4.w}, rkc[4] = {rk4.x, rk4.y, rk4.z, rk4.w};
      float kkr[4], ss = 0.f;
#pragma unroll
      for (int e = 0; e < 4; ++e) { kkr[e] = kf[e] * kkc[e]; ss += kkr[e] * kkr[e]; }
      ss = allreduce16(ss);
      const float inv = __builtin_amdgcn_rsqf(fmaxf(ss, 1e-24f));
      float kk[4], w[4], kka[4], kd[4], cbp = 0.f;
#pragma unroll
      for (int e = 0; e < 4; ++e) {
        kk[e] = kkr[e] * inv; w[e] = __expf(-(float)pe[e]); kka[e] = kk[e] * af[e];
        kd[e] = kf[e] * (1.f + (af[e] - 1.f) * kac[e]); cbp += rf[e] * kd[e] * rkc[e];
      }
      cbp = allreduce16(cbp);
      float* d0 = dat + stj * 320 + 4 * scg;
      *(float4*)(d0) = make_float4(kk[0], kk[1], kk[2], kk[3]);
      *(float4*)(d0 + 64) = make_float4(w[0], w[1], w[2], w[3]);
      *(float4*)(d0 + 128) = make_float4(kka[0], kka[1], kka[2], kka[3]);
      *(float4*)(d0 + 192) = make_float4(kd[0], kd[1], kd[2], kd[3]);
      *(float4*)(d0 + 256) = make_float4(rf[0], rf[1], rf[2], rf[3]);
      dat[5120 + stj * 16 + scg] = (float)pv;
      if (rg == 0 && scg == 0) CB[((size_t)dir * T_ALL + rowof(cidx, stj)) * 16 + h] = cbp;
    };
    auto yflush = [&](int cidx) {
      const float4 y4 = *(const float4*)((const float*)(smem + (cidx & 1) * SC_BUF) + 5376 + (stj * 16 + scg) * 4);
      YB[(size_t)rowof(cidx, stj) * DM + h * 64 + 16 * rg + scg] = (bf16_t)f2bf((y4.x + y4.y) + (y4.z + y4.w));
    };
    gload(0);
    const int NCH = 528;
    for (int c = 0; c < NCH; ++c) {
      lwrite(c);
      __syncthreads();
      if (c > 0) yflush(c - 1);
      if (c + 1 < NCH) gload(c + 1);
      const float* dat = (const float*)(smem + (c & 1) * SC_BUF);
      float* yp = ((g & 3) == 0) ? ((float*)(smem + (c & 1) * SC_BUF) + 5376 + rl * 4 + (g >> 2)) : ((float*)(smem + 2 * SC_BUF) + (lane & 63));
      const float* dl = dat + 4 * g;
      const float* vl = dat + 5120 + rl;
#define SC_LOAD(jj_, K_, W_, A_, D_, R_, V_) do { const float* d_ = dl + (jj_) * 320; K_ = *(const f32x4*)(d_); W_ = *(const f32x4*)(d_ + 64); \
        A_ = *(const f32x4*)(d_ + 128); D_ = *(const f32x4*)(d_ + 192); R_ = *(const f32x4*)(d_ + 256); V_ = vl[(jj_) * 16]; } while (0)
#define SC_STEP(jj_, K_, W_, A_, D_, R_, V_) do { \
        f32x2 pa2 = Sa * K_.xy; pa2 = Sb * K_.zw + pa2; \
        const float sa = allreduce16(pa2.x + pa2.y); \
        const f32x2 nsa = {-sa, -sa}, v2 = {V_, V_}; \
        f32x2 ta = v2 * D_.xy; ta = nsa * A_.xy + ta; Sa = Sa * W_.xy + ta; \
        f32x2 tb = v2 * D_.zw; tb = nsa * A_.zw + tb; Sb = Sb * W_.zw + tb; \
        f32x2 ya = Sa * R_.xy; ya = Sb * R_.zw + ya; \
        float y = ya.x + ya.y; y += dpp_f<0xB1>(y); y += dpp_f<0x4E>(y); \
        yp[(jj_) * 64] = y; } while (0)
      f32x4 k0, w0, a0, d0, r0, k1, w1, a1, d1, r1; float v0, v1;
      SC_LOAD(0, k0, w0, a0, d0, r0, v0);
#pragma unroll
      for (int jj = 0; jj < 16; jj += 2) {
        SC_LOAD(jj + 1, k1, w1, a1, d1, r1, v1);
        SC_STEP(jj, k0, w0, a0, d0, r0, v0);
        if (jj + 2 < 16) SC_LOAD(jj + 2, k0, w0, a0, d0, r0, v0);
        SC_STEP(jj + 1, k1, w1, a1, d1, r1, v1);
      }
    }
    __syncthreads();
    yflush(NCH - 1);
    __syncthreads();
    if (tid == 0) shi[0] = atomicAdd(itemCnt, 1);
    __syncthreads();
    item = shi[0];
  }
  __syncthreads();
  convert_weights(p, 3 * j, smem, 0, 2, (int*)(wsp(p) + OFF_MISC + MISC_CNT) + 8192 + 4 + cset);
}
typedef _Float16 f16x8 __attribute__((ext_vector_type(8)));
DI void phase_rwkv_post(const Params& p, int j, int nrows) {
  const bf16_t* Y0 = (const bf16_t*)outp(p, RO_Y0); const bf16_t* Y1 = (const bf16_t*)actp(p, RA_Y1);
  const f16_t* VB = (const f16_t*)actp(p, RA_V); const float* CB = (const float*)outp(p, RO_CB);
  bf16_t* Z0 = (bf16_t*)actp(p, RA_Z0);
  const float* lg = p.in[I_RLNG] + j * 1024; const float* lb = p.in[I_RLNB] + j * 1024;
  const int lane = tidx() & 63, wid = tidx() >> 6;
  const int c0 = 16 * lane, h = lane >> 2;
  float gv[16], bv[16];
#pragma unroll
  for (int q4 = 0; q4 < 4; ++q4) {
    const float4 g4 = *(const float4*)(lg + c0 + 4 * q4), b4 = *(const float4*)(lb + c0 + 4 * q4);
    gv[4 * q4] = g4.x; gv[4 * q4 + 1] = g4.y; gv[4 * q4 + 2] = g4.z; gv[4 * q4 + 3] = g4.w;
    bv[4 * q4] = b4.x; bv[4 * q4 + 1] = b4.y; bv[4 * q4 + 2] = b4.z; bv[4 * q4 + 3] = b4.w;
  }
  for (int row = (blockIdx.x * 4 + wid) * 2; row < nrows; row += gridDim.x * 8) {
    uint4 a0[2], a1[2], b0[2], b1[2]; f16x8 v0[2], v1[2]; float cb[2];
#pragma unroll
    for (int r = 0; r < 2; ++r) {
      const size_t off = (size_t)(row + r) * DM + c0;
      a0[r] = *(const uint4*)(Y0 + off); a1[r] = *(const uint4*)(Y0 + off + 8);
      b0[r] = *(const uint4*)(Y1 + off); b1[r] = *(const uint4*)(Y1 + off + 8);
      v0[r] = *(const f16x8*)(VB + off); v1[r] = *(const f16x8*)(VB + off + 8);
      cb[r] = CB[(size_t)(row + r) * 16 + h] + CB[((size_t)T_ALL + row + r) * 16 + h];
    }
#pragma unroll
    for (int r = 0; r < 2; ++r) {
      const unsigned ya[8] = {a0[r].x, a0[r].y, a0[r].z, a0[r].w, a1[r].x, a1[r].y, a1[r].z, a1[r].w};
      const unsigned yb[8] = {b0[r].x, b0[r].y, b0[r].z, b0[r].w, b1[r].x, b1[r].y, b1[r].z, b1[r].w};
      float y[16], sm = 0.f;
#pragma unroll
      for (int e = 0; e < 8; ++e) { y[2 * e] = bflo(ya[e]) + bflo(yb[e]); y[2 * e + 1] = bfhi(ya[e]) + bfhi(yb[e]); sm += y[2 * e] + y[2 * e + 1]; }
      sm += dpp_f<0xB1>(sm); sm += dpp_f<0x4E>(sm);
      const float mu = sm * (1.f / 64.f);
      float q = 0.f;
#pragma unroll
      for (int e = 0; e < 16; ++e) { const float d = y[e] - mu; q += d * d; }
      q += dpp_f<0xB1>(q); q += dpp_f<0x4E>(q);
      const float rs = __builtin_amdgcn_rsqf(q * (1.f / 64.f) + 6.4e-4f);
      unsigned o[8];
#pragma unroll
      for (int e = 0; e < 8; ++e) {
        const float va = e < 4 ? (float)v0[r][2 * e] : (float)v1[r][2 * e - 8], vb = e < 4 ? (float)v0[r][2 * e + 1] : (float)v1[r][2 * e - 7];
        const float z0 = (y[2 * e] - mu) * rs * gv[2 * e] + bv[2 * e] + cb[r] * va;
        const float z1 = (y[2 * e + 1] - mu) * rs * gv[2 * e + 1] + bv[2 * e + 1] + cb[r] * vb;
        o[e] = pk2(z0, z1);
      }
      const size_t off = (size_t)(row + r) * DM + c0;
      *(uint4*)(Z0 + off) = make_uint4(o[0], o[1], o[2], o[3]);
      *(uint4*)(Z0 + off + 8) = make_uint4(o[4], o[5], o[6], o[7]);
    }
  }
}
DI void phase_rwkv_gate(const Params& p, unsigned char* smem, int rowtiles) {
  const bf16_t* wb = (const bf16_t*)(wsp(p) + OFF_WB);
  EpiMulZ epi{(bf16_t*)actp(p, RA_ZB), (const bf16_t*)actp(p, RA_Z0)};
  XCD_FOR(t, 512) { const int g = t >> 6, idx = t & 63; gemm_tile_big(smem, (const bf16_t*)outp(p, RO_LG), 192, wb + RW_G2, 192, 192, 8 * g + (idx & 7), idx >> 3, epi); }
  if (rowtiles > 128) XCD_FOR(t, 32) gemm_tile<false>(smem, (const bf16_t*)outp(p, RO_LG), nullptr, nullptr, 192, wb + RW_G2, 192, 192, 128 + (t & 3), t >> 2, epi);
}

constexpr size_t MA_HB = 0, MA_Q = 33, MA_K = 50, MA_V = 67, MA_O = 100, MA_GT = 133, MA_CT = 135, MA_NL = 201, MA_DEC = 202, MA_H1 = 203, MA_ZB = 0;
DI void phase_ml_in(const Params& p, int j, unsigned char* smem) {
  const bf16_t* wb = (const bf16_t*)(wsp(p) + OFF_WB);
  const bf16_t* hb = (const bf16_t*)actp(p, MA_HB);
  const float* bias = p.in[I_MBIN] + (size_t)j * 3088;
  auto mk = [&](int tn) {
    const int n0 = tn * 128;
    EpiMlIn epi;
    epi.bias = bias; epi.scale = 1.f; epi.act = 0;
    if (n0 < 512) { epi.C = (bf16_t*)actp(p, MA_Q); epi.ldc = 512; }
    else if (n0 < 1024) { epi.C = (bf16_t*)actp(p, MA_K) - 512; epi.ldc = 512; epi.scale = 0.08838834764831845f; }
    else if (n0 < 2048) { epi.C = (bf16_t*)actp(p, MA_V) - 1024; epi.ldc = 1024; }
    else { epi.C = (bf16_t*)actp(p, MA_O) - 2048; epi.ldc = 1024; epi.act = 1; }
    return epi;
  };
  XCD_FOR(t, 64 * 24) { const int g = t / 192, idx = t % 192, tn = idx >> 3; const EpiMlIn epi = mk(tn); gemm_tile_big(smem, hb, DM, wb + ML_WIN, DM, 1024, 8 * g + (idx & 7), tn, epi); }
  XCD_FOR(t, 96) { const int tn = t >> 2; const EpiMlIn epi = mk(tn); gemm_tile<false>(smem, hb, nullptr, nullptr, DM, wb + ML_WIN, DM, 1024, 128 + (t & 3), tn, epi); }
  XCD_FOR(t, 132) { EpiMlGate epi{(float*)actp(p, MA_GT), bias + 3072}; gemm_tile<false>(smem, hb, nullptr, nullptr, DM, wb + ML_WG, DM, 1024, t, 0, epi); }
}
DI int ml_row(int b, int dir, int c, int s) {
  if (c < 2) { const int pp = c * 128 + s; return T_LAT + b * 256 + (dir ? 255 - pp : pp); }
  const int pp = (c - 2) * 128 + s; return b * 8192 + (dir ? 8191 - pp : pp);
}
DI void ml_gates(const float* GT, int b, int head, int dir, int c, float* bc, float* li, float* tmp) {
  const int tid = tidx();
  if (tid < 128) {
    const int row = ml_row(b, dir, c, tid);
    li[tid] = GT[(size_t)row * 16 + dir * 8 + head];
    tmp[tid] = GT[(size_t)row * 16 + dir * 8 + 4 + head];
  }
  __syncthreads();
  if (tid < 128) {
    const int ln = tid & 63;
    float v = tmp[tid];
#pragma unroll
    for (int d = 1; d < 64; d <<= 1) { const float t = __shfl_up(v, d); if (ln >= d) v += t; }
    if (tid == 63) tmp[128 + 0] = v;
    bc[tid] = v;
  }
  __syncthreads();
  if (tid >= 64 && tid < 128) bc[tid] += tmp[128];
  __syncthreads();
}
DI void phase_ml_cloc(const Params& p, unsigned char* smem) {
  const bf16_t* KB = (const bf16_t*)actp(p, MA_K); const bf16_t* VB = (const bf16_t*)actp(p, MA_V); const float* GT = (const float*)actp(p, MA_GT);
  bf16_t* CT = (bf16_t*)actp(p, MA_CT); float* NL = (float*)actp(p, MA_NL); float* DEC = (float*)actp(p, MA_DEC);
  const int tid = tidx(), lane = tid & 63, wv = tid >> 6, r32 = lane & 31, hh = lane >> 5;
  unsigned char* sVT = smem;
  unsigned char* sKT = smem + 36864;
  float* bc = (float*)(smem + 55296); float* li = bc + 128; float* tmp = li + 128; float* wts = tmp + 128;
  for (int item = blockIdx.x; item < 16 * 66; item += gridDim.x) {
    const int seq = item / 66, c = item % 66, dir = seq & 1, bh = seq >> 1, b = bh >> 2, head = bh & 3;
    ml_gates(GT, b, head, dir, c, bc, li, tmp);
    if (tid < 128) wts[tid] = __expf(bc[127] - bc[tid] + li[tid]);
    __syncthreads();
    f32x16 acc[4][2];
#pragma unroll
    for (int a = 0; a < 4; ++a)
#pragma unroll
      for (int bb = 0; bb < 2; ++bb)
#pragma unroll
        for (int i = 0; i < 16; ++i) acc[a][bb][i] = 0.f;
    float nacc = 0.f;
    for (int half = 0; half < 2; ++half) {
      {
        uint4 dv[8];
#pragma unroll
        for (int q = 0; q < 8; ++q) {
          const int cidx = tid + 256 * q, s_ = cidx & 63, vc = cidx >> 6;
          dv[q] = *(const uint4*)(VB + (size_t)ml_row(b, dir, c, half * 64 + s_) * DM + head * 256 + vc * 8);
        }
        uint4 dk[4];
#pragma unroll
        for (int q = 0; q < 4; ++q) {
          const int cidx = tid + 256 * q, s_ = cidx & 63, kc = cidx >> 6;
          dk[q] = *(const uint4*)(KB + (size_t)ml_row(b, dir, c, half * 64 + s_) * 512 + head * 128 + kc * 8);
        }
#pragma unroll
        for (int q = 0; q < 8; ++q) {
          const int cidx = tid + 256 * q, s_ = cidx & 63, vc = cidx >> 6;
          const unsigned dd[4] = {dv[q].x, dv[q].y, dv[q].z, dv[q].w};
#pragma unroll
          for (int e = 0; e < 4; ++e) {
            *(bf16_t*)(sVT + (vc * 8 + 2 * e) * 144 + s_ * 2) = (bf16_t)(dd[e] & 0xffff);
            *(bf16_t*)(sVT + (vc * 8 + 2 * e + 1) * 144 + s_ * 2) = (bf16_t)(dd[e] >> 16);
          }
        }
#pragma unroll
        for (int q = 0; q < 4; ++q) {
          const int cidx = tid + 256 * q, s_ = cidx & 63, kc = cidx >> 6;
          const float w = wts[half * 64 + s_];
          const unsigned dd[4] = {dk[q].x, dk[q].y, dk[q].z, dk[q].w};
#pragma unroll
          for (int e = 0; e < 4; ++e) {
            *(bf16_t*)(sKT + (kc * 8 + 2 * e) * 144 + s_ * 2) = (bf16_t)f2bf(bflo(dd[e]) * w);
            *(bf16_t*)(sKT + (kc * 8 + 2 * e + 1) * 144 + s_ * 2) = (bf16_t)f2bf(bfhi(dd[e]) * w);
          }
        }
      }
      __syncthreads();
      if (tid < 128) { const bf16_t* kr = (const bf16_t*)(sKT + tid * 144); for (int s = 0; s < 64; ++s) nacc += bf2f(kr[s]); }
#pragma unroll
      for (int ks = 0; ks < 4; ++ks) {
        bf16x8 kf[4], vf[2];
#pragma unroll
        for (int a = 0; a < 4; ++a) kf[a] = *(const bf16x8*)(sKT + (32 * a + r32) * 144 + ks * 32 + hh * 16);
#pragma unroll
        for (int bb = 0; bb < 2; ++bb) vf[bb] = *(const bf16x8*)(sVT + (64 * wv + 32 * bb + r32) * 144 + ks * 32 + hh * 16);
#pragma unroll
        for (int a = 0; a < 4; ++a)
#pragma unroll
          for (int bb = 0; bb < 2; ++bb) acc[a][bb] = mfma32(kf[a], vf[bb], acc[a][bb]);
      }
      __syncthreads();
    }
    bf16_t* ct = CT + (size_t)item * 32768;
#pragma unroll
    for (int a = 0; a < 4; ++a)
#pragma unroll
      for (int bb = 0; bb < 2; ++bb)
#pragma unroll
        for (int ig = 0; ig < 4; ++ig) {
          const int v = 64 * wv + 32 * bb + r32, k = 32 * a + 8 * ig + 4 * hh;
          st_bf16x4(ct + v * 128 + k, make_float4(acc[a][bb][4 * ig], acc[a][bb][4 * ig + 1], acc[a][bb][4 * ig + 2], acc[a][bb][4 * ig + 3]));
        }
    if (tid < 128) NL[(size_t)item * 128 + tid] = nacc;
    if (tid == 0) DEC[item] = __expf(bc[127]);
    __syncthreads();
  }
}
DI void phase_ml_cscan(const Params& p) {
  bf16_t* CT = (bf16_t*)actp(p, MA_CT); float* NL = (float*)actp(p, MA_NL); const float* DEC = (const float*)actp(p, MA_DEC);
  const int gt = blockIdx.x * 256 + tidx(), nth = gridDim.x * 256;
  for (int e = gt; e < 16 * 4096; e += nth) {
    const int seq = e >> 12, idx = (e & 4095) * 8;
    float run[8];
#pragma unroll
    for (int i = 0; i < 8; ++i) run[i] = 0.f;
    bf16_t* base = CT + (size_t)seq * 66 * 32768 + idx;
#pragma unroll 1
    for (int c0 = 0; c0 < 66; c0 += 11) {
      uint4 d[11]; float dc[11];
#pragma unroll
      for (int q = 0; q < 11; ++q) { d[q] = *(const uint4*)(base + (size_t)(c0 + q) * 32768); dc[q] = DEC[seq * 66 + c0 + q]; }
#pragma unroll
      for (int q = 0; q < 11; ++q) {
        *(uint4*)(base + (size_t)(c0 + q) * 32768) = make_uint4(pk2(run[0], run[1]), pk2(run[2], run[3]), pk2(run[4], run[5]), pk2(run[6], run[7]));
        const float dec = dc[q];
        run[0] = dec * run[0] + bflo(d[q].x); run[1] = dec * run[1] + bfhi(d[q].x); run[2] = dec * run[2] + bflo(d[q].y); run[3] = dec * run[3] + bfhi(d[q].y);
        run[4] = dec * run[4] + bflo(d[q].z); run[5] = dec * run[5] + bfhi(d[q].z); run[6] = dec * run[6] + bflo(d[q].w); run[7] = dec * run[7] + bfhi(d[q].w);
      }
    }
  }
  if (tidx() < 4) {
    for (int e = blockIdx.x * 4 + tidx(); e < 16 * 128; e += gridDim.x * 4) {
      const int seq = e >> 7, k = e & 127; float run = 0.f;
#pragma unroll 1
      for (int c0 = 0; c0 < 66; c0 += 11) {
        float d[11], dc[11];
#pragma unroll
        for (int q = 0; q < 11; ++q) { d[q] = NL[(size_t)(seq * 66 + c0 + q) * 128 + k]; dc[q] = DEC[seq * 66 + c0 + q]; }
#pragma unroll
        for (int q = 0; q < 11; ++q) { NL[(size_t)(seq * 66 + c0 + q) * 128 + k] = run; run = dc[q] * run + d[q]; }
      }
    }
  }
}
DI void phase_ml_out(const Params& p, unsigned char* smem) {
  const bf16_t* QB = (const bf16_t*)actp(p, MA_Q); const bf16_t* KB = (const bf16_t*)actp(p, MA_K); const bf16_t* VB = (const bf16_t*)actp(p, MA_V);
  const float* GT = (const float*)actp(p, MA_GT); const bf16_t* CT = (const bf16_t*)actp(p, MA_CT); const float* NL = (const float*)actp(p, MA_NL);
  const int tid = tidx(), lane = tid & 63, wv = tid >> 6, r32 = lane & 31, hh = lane >> 5;
  unsigned char* sVT = smem + 34816;
  float* bc = (float*)(smem + 69632); float* li = bc + 128; float* tmp = li + 128; float* n0s = tmp + 128;
  for (int item = blockIdx.x; item < 16 * 66; item += gridDim.x) {
    const int seq = item / 66, c = item % 66, dir = seq & 1, bh = seq >> 1, b = bh >> 2, head = bh & 3;
    bf16_t* HD = dir ? (bf16_t*)actp(p, MA_H1) : (bf16_t*)outp(p, 0);
    ml_gates(GT, b, head, dir, c, bc, li, tmp);
    if (tid < 128) n0s[tid] = NL[(size_t)item * 128 + tid];
    __syncthreads();
    const int tq = 32 * wv + r32;
    const int qrow = ml_row(b, dir, c, tq);
    const float btq = bc[tq];
    unsigned char* sP = smem + wv * 8192 + lane * 16;
    float den = 0.f, qn = 0.f;
    {
      bf16x8 Qf[8];
#pragma unroll
      for (int ks = 0; ks < 8; ++ks) Qf[ks] = *(const bf16x8*)(QB + (size_t)qrow * 512 + head * 128 + 16 * ks + 8 * hh);
#pragma unroll
      for (int ks = 0; ks < 8; ++ks)
#pragma unroll
        for (int e = 0; e < 8; ++e) qn += bf2f((unsigned short)Qf[ks][e]) * n0s[16 * ks + 8 * hh + e];
      qn += __shfl_xor(qn, 32);
#pragma unroll 1
      for (int si = 0; si <= wv; ++si) {
        f32x16 sa;
#pragma unroll
        for (int i = 0; i < 16; ++i) sa[i] = 0.f;
        const bf16_t* kr = KB + (size_t)ml_row(b, dir, c, 32 * si + r32) * 512 + head * 128 + 8 * hh;
#pragma unroll
        for (int ks = 0; ks < 8; ++ks) sa = mfma32(*(const bf16x8*)(kr + 16 * ks), Qf[ks], sa);
#pragma unroll
        for (int i = 0; i < 16; ++i) {
          const int sp = 32 * si + (i & 3) + 8 * (i >> 2) + 4 * hh;
          const float f = (sp <= tq) ? __expf(btq - bc[sp] + li[sp]) : 0.f;
          sa[i] *= f; den += sa[i];
        }
        *(bf16x8*)(sP + (2 * si) * 1024) = pack8(sa, 0);
        *(bf16x8*)(sP + (2 * si + 1) * 1024) = pack8(sa, 1);
      }
    }
    den += __shfl_xor(den, 32);
    const float ebt = __expf(btq);
    den = ebt * qn + den;
    const float rden = 1.f / fmaxf(fabsf(den), 1.f);
    const bf16_t* ct = CT + (size_t)item * 32768;
    for (int vh = 0; vh < 2; ++vh) {
      {
        uint4 dv[8];
#pragma unroll
        for (int q = 0; q < 8; ++q) {
          const int cidx = tid + 256 * q, s_ = cidx & 127, vc = cidx >> 7;
          dv[q] = *(const uint4*)(VB + (size_t)ml_row(b, dir, c, s_) * DM + head * 256 + vh * 128 + vc * 8);
        }
#pragma unroll
        for (int q = 0; q < 8; ++q) {
          const int cidx = tid + 256 * q, s_ = cidx & 127, vc = cidx >> 7;
          const unsigned dd[4] = {dv[q].x, dv[q].y, dv[q].z, dv[q].w};
          const int pos = (s_ & ~15) | perm16(s_ & 15);
#pragma unroll
          for (int e = 0; e < 4; ++e) {
            *(bf16_t*)(sVT + (vc * 8 + 2 * e) * 272 + pos * 2) = (bf16_t)(dd[e] & 0xffff);
            *(bf16_t*)(sVT + (vc * 8 + 2 * e + 1) * 272 + pos * 2) = (bf16_t)(dd[e] >> 16);
          }
        }
      }
      __syncthreads();
#pragma unroll 1
      for (int vq = 0; vq < 2; ++vq) {
        f32x16 acc[2];
#pragma unroll
        for (int vi = 0; vi < 2; ++vi)
#pragma unroll
          for (int i = 0; i < 16; ++i) acc[vi][i] = 0.f;
        {
          bf16x8 Qg[8];
#pragma unroll
          for (int ks = 0; ks < 8; ++ks) Qg[ks] = *(const bf16x8*)(QB + (size_t)qrow * 512 + head * 128 + 16 * ks + 8 * hh);
#pragma unroll
          for (int vi = 0; vi < 2; ++vi) {
            const bf16_t* cr = ct + (size_t)(vh * 128 + 64 * vq + 32 * vi + r32) * 128 + 8 * hh;
#pragma unroll
            for (int ks = 0; ks < 8; ++ks) acc[vi] = mfma32(*(const bf16x8*)(cr + 16 * ks), Qg[ks], acc[vi]);
          }
        }
#pragma unroll
        for (int vi = 0; vi < 2; ++vi)
#pragma unroll
          for (int i = 0; i < 16; ++i) acc[vi][i] *= ebt;
#pragma unroll
        for (int kst = 0; kst < 8; ++kst) {
          if (kst < 2 * (wv + 1)) {
            const bf16x8 pf = *(const bf16x8*)(sP + kst * 1024);
#pragma unroll
            for (int vi = 0; vi < 2; ++vi) {
              const bf16x8 vf = *(const bf16x8*)(sVT + (64 * vq + 32 * vi + r32) * 272 + kst * 32 + hh * 16);
              acc[vi] = mfma32(vf, pf, acc[vi]);
            }
          }
        }
#pragma unroll
        for (int vi = 0; vi < 2; ++vi)
#pragma unroll
          for (int ig = 0; ig < 4; ++ig) {
            const int v = vh * 128 + 64 * vq + 32 * vi + 8 * ig + 4 * hh;
            st_bf16x4(HD + (size_t)qrow * DM + head * 256 + v,
                      make_float4(acc[vi][4 * ig] * rden, acc[vi][4 * ig + 1] * rden, acc[vi][4 * ig + 2] * rden, acc[vi][4 * ig + 3] * rden));
          }
      }
      __syncthreads();
    }
  }
}
DI void phase_ml_post(const Params& p, int j) {
  const bf16_t* H0 = (const bf16_t*)outp(p, 0); const bf16_t* H1 = (const bf16_t*)actp(p, MA_H1); const bf16_t* OB = (const bf16_t*)actp(p, MA_O);
  bf16_t* ZB = (bf16_t*)actp(p, MA_ZB);
  const float* ng = p.in[I_MNG] + j * 1024;
  const int lane = tidx() & 63, wid = tidx() >> 6;
  for (int row = blockIdx.x * 4 + wid; row < T_ALL; row += gridDim.x * 4) {
    const int c0 = 16 * lane;
    const size_t off = (size_t)row * DM + c0;
    const uint4 a0 = *(const uint4*)(H0 + off), a1 = *(const uint4*)(H0 + off + 8), b0 = *(const uint4*)(H1 + off), b1 = *(const uint4*)(H1 + off + 8);
    const uint4 o0 = *(const uint4*)(OB + off), o1 = *(const uint4*)(OB + off + 8);
    const unsigned ya[8] = {a0.x, a0.y, a0.z, a0.w, a1.x, a1.y, a1.z, a1.w}, yb[8] = {b0.x, b0.y, b0.z, b0.w, b1.x, b1.y, b1.z, b1.w},
                   oo[8] = {o0.x, o0.y, o0.z, o0.w, o1.x, o1.y, o1.z, o1.w};
    float y[16], q = 0.f;
#pragma unroll
    for (int e = 0; e < 8; ++e) { y[2 * e] = bflo(ya[e]) + bflo(yb[e]); y[2 * e + 1] = bfhi(ya[e]) + bfhi(yb[e]); q += y[2 * e] * y[2 * e] + y[2 * e + 1] * y[2 * e + 1]; }
    q = allreduce16(q);
    const float rs = __builtin_amdgcn_rsqf(q * (1.f / 256.f) + 1e-6f);
    unsigned o[8];
#pragma unroll
    for (int e = 0; e < 8; ++e) {
      const int c = c0 + 2 * e;
      o[e] = pk2(y[2 * e] * rs * ng[c] * bflo(oo[e]), y[2 * e + 1] * rs * ng[c + 1] * bfhi(oo[e]));
    }
    *(uint4*)(ZB + off) = make_uint4(o[0], o[1], o[2], o[3]);
    *(uint4*)(ZB + off + 8) = make_uint4(o[4], o[5], o[6], o[7]);
  }
}

constexpr size_t DA_HB = 0, DA_Q = 33, DA_K = 66, DA_VT = 99, DA_OB = 132;
constexpr int AT_K = 64 * 272, AT_V = 128 * 144, AT_BUF = AT_K + AT_V;
DI void phase_da_qkv(const Params& p, unsigned char* smem) {
  const bf16_t* wb = (const bf16_t*)(wsp(p) + OFF_WB);
  EpiDaQkv epi{(bf16_t*)actp(p, DA_Q), (bf16_t*)actp(p, DA_K), (bf16_t*)actp(p, DA_VT)};
  XCD_FOR(t, 64 * 24) { const int g = t / 192, idx = t % 192; gemm_tile_big(smem, (const bf16_t*)actp(p, DA_HB), DM, wb + DA_QKV, DM, 1024, 8 * g + (idx & 7), idx >> 3, epi); }
  XCD_FOR(t, 96) gemm_tile<false>(smem, (const bf16_t*)actp(p, DA_HB), nullptr, nullptr, DM, wb + DA_QKV, DM, 1024, 128 + (t & 3), t >> 2, epi);
}
DI void phase_da_attn(const Params& p, int j, unsigned char* smem) {
  const bf16_t* QB = (const bf16_t*)actp(p, DA_Q); const bf16_t* KB = (const bf16_t*)actp(p, DA_K); const bf16_t* VT = (const bf16_t*)actp(p, DA_VT);
  bf16_t* OB = (bf16_t*)actp(p, DA_OB);
  const int tid = tidx(), lane = tid & 63, wv = tid >> 6, r32 = lane & 31, hh = lane >> 5;
  const int qh = wv & 1, mp = wv >> 1;
  const float lambda_init = 0.47071301834358416f;
  float lam_full;
  {
    const float* lm = p.in[I_DLAM] + (size_t)j * 256;
    float d1 = 0.f, d2 = 0.f;
    for (int i = 0; i < 64; ++i) { d1 += lm[i] * lm[64 + i]; d2 += lm[128 + i] * lm[192 + i]; }
    lam_full = __expf(d1) - __expf(d2) + lambda_init;
  }
  const float* ng = p.in[I_DNG] + (size_t)j * 128;
  const float csc = 0.125f * 1.4426950408889634f;
  XCD_FOR(slot, 2048 + 64) {
    const int xq = slot / 264, iq = slot - xq * 264;
    const int item = iq < 256 ? xq * 256 + iq : 2048 + xq * 8 + (iq - 256);
    int bh, qbase, kt0, nkt;
    if (item < 2048) { bh = item >> 7; qbase = (bh >> 3) * 8192 + 64 * (item & 127); kt0 = 0; nkt = 132; }
    else { const int it = item - 2048; bh = it >> 2; qbase = T_LAT + (bh >> 3) * 256 + 64 * (it & 3); kt0 = 128; nkt = 4; }
    const int b = bh >> 3, head = bh & 7;
    const int qrow = qbase + 32 * qh + r32;
    bf16x8 Qf[4];
#pragma unroll
    for (int ks = 0; ks < 4; ++ks) Qf[ks] = *(const bf16x8*)(QB + (size_t)qrow * DM + head * 128 + 64 * mp + 16 * ks + 8 * hh);
    f32x16 O[4];
#pragma unroll
    for (int vi = 0; vi < 4; ++vi)
#pragma unroll
      for (int i = 0; i < 16; ++i) O[vi][i] = 0.f;
    float mrun = -1e30f, lsum = 0.f;
    uint4 rk0, rk1, rk2, rk3, rv0, rv1, rv2, rv3;
    const int krow_l = tid >> 4, kcc = tid & 15, vrow_l = tid >> 3, vcc = tid & 7;
#define AT_GLOAD(kt_) do { const int kt__ = (kt_); const int krow0 = kt__ < 128 ? b * 8192 + 64 * kt__ : T_LAT + b * 256 + 64 * (kt__ - 128); \
      const bf16_t* kp_ = KB + (size_t)(krow0 + krow_l) * DM + head * 128 + kcc * 8; \
      const bf16_t* vp_ = VT + ((size_t)bh * 128 + vrow_l) * 8448 + 64 * kt__ + vcc * 8; \
      rk0 = *(const uint4*)(kp_); rk1 = *(const uint4*)(kp_ + 16 * DM); rk2 = *(const uint4*)(kp_ + 32 * DM); rk3 = *(const uint4*)(kp_ + 48 * DM); \
      rv0 = *(const uint4*)(vp_); rv1 = *(const uint4*)(vp_ + 32 * 8448); rv2 = *(const uint4*)(vp_ + 64 * 8448); rv3 = *(const uint4*)(vp_ + 96 * 8448); } while (0)
#define AT_LWRITE(buf_) do { unsigned char* kb_ = smem + (buf_) * AT_BUF + krow_l * 272 + kcc * 16; unsigned char* vb_ = smem + (buf_) * AT_BUF + AT_K + vrow_l * 144 + vcc * 16; \
      *(uint4*)(kb_) = rk0; *(uint4*)(kb_ + 16 * 272) = rk1; *(uint4*)(kb_ + 32 * 272) = rk2; *(uint4*)(kb_ + 48 * 272) = rk3; \
      *(uint4*)(vb_) = rv0; *(uint4*)(vb_ + 32 * 144) = rv1; *(uint4*)(vb_ + 64 * 144) = rv2; *(uint4*)(vb_ + 96 * 144) = rv3; } while (0)
    AT_GLOAD(kt0); AT_LWRITE(0);
    __syncthreads();
    for (int it = 0; it < nkt; ++it) {
      const bool more = it + 1 < nkt;
      if (more) AT_GLOAD(kt0 + it + 1);
      const unsigned char* sK = smem + (it & 1) * AT_BUF; const unsigned char* sV = sK + AT_K;
      f32x16 s0, s1;
#pragma unroll
      for (int i = 0; i < 16; ++i) { s0[i] = 0.f; s1[i] = 0.f; }
#pragma unroll
      for (int ks = 0; ks < 4; ++ks) {
        const bf16x8 k0 = *(const bf16x8*)(sK + r32 * 272 + mp * 128 + ks * 32 + hh * 16);
        const bf16x8 k1 = *(const bf16x8*)(sK + (32 + r32) * 272 + mp * 128 + ks * 32 + hh * 16);
        s0 = mfma32(k0, Qf[ks], s0); s1 = mfma32(k1, Qf[ks], s1);
      }
      float mx = s0[0];
#pragma unroll
      for (int i = 1; i < 16; ++i) mx = fmaxf(mx, s0[i]);
#pragma unroll
      for (int i = 0; i < 16; ++i) mx = fmaxf(mx, s1[i]);
      mx = fmaxf(mx, __shfl_xor(mx, 32));
      const float mnew = fmaxf(mrun, mx * csc);
      if (__any(mnew > mrun)) {
        const float alpha = __builtin_amdgcn_exp2f(mrun - mnew);
        lsum *= alpha;
#pragma unroll
        for (int vi = 0; vi < 4; ++vi)
#pragma unroll
          for (int i = 0; i < 16; ++i) O[vi][i] *= alpha;
      }
      mrun = mnew;
      float ps = 0.f;
#pragma unroll
      for (int i = 0; i < 16; ++i) { s0[i] = __builtin_amdgcn_exp2f(s0[i] * csc - mnew); s1[i] = __builtin_amdgcn_exp2f(s1[i] * csc - mnew); ps += s0[i] + s1[i]; }
      lsum += ps;
      bf16x8 Pf[4];
      Pf[0] = pack8(s0, 0); Pf[1] = pack8(s0, 1); Pf[2] = pack8(s1, 0); Pf[3] = pack8(s1, 1);
#pragma unroll
      for (int kst = 0; kst < 4; ++kst)
#pragma unroll
        for (int vi = 0; vi < 4; ++vi) {
          const bf16x8 vf = *(const bf16x8*)(sV + (32 * vi + r32) * 144 + kst * 32 + hh * 16);
          O[vi] = mfma32(vf, Pf[kst], O[vi]);
        }
      if (more) AT_LWRITE((it + 1) & 1);
      __syncthreads();
    }
    lsum += __shfl_xor(lsum, 32);
    const float rl = 1.f / lsum;
    float* osh = (float*)smem;
    if (mp == 1) {
#pragma unroll
      for (int vi = 0; vi < 4; ++vi)
#pragma unroll
        for (int i = 0; i < 16; ++i) osh[(32 * qh + r32) * 129 + 32 * vi + (i & 3) + 8 * (i >> 2) + 4 * hh] = O[vi][i] * rl;
    }
    __syncthreads();
    if (mp == 0) {
      float ss = 0.f;
#pragma unroll
      for (int vi = 0; vi < 4; ++vi)
#pragma unroll
        for (int i = 0; i < 16; ++i) {
          const float o = O[vi][i] * rl - lam_full * osh[(32 * qh + r32) * 129 + 32 * vi + (i & 3) + 8 * (i >> 2) + 4 * hh];
          O[vi][i] = o; ss += o * o;
        }
      ss += __shfl_xor(ss, 32);
      const float rs = __builtin_amdgcn_rsqf(ss * (1.f / 128.f) + 1e-5f) * (1.f - lambda_init);
#pragma unroll
      for (int vi = 0; vi < 4; ++vi)
#pragma unroll
        for (int ig = 0; ig < 4; ++ig) {
          const int v = 32 * vi + 8 * ig + 4 * hh;
          const float4 g4 = *(const float4*)(ng + v);
          st_bf16x4(OB + (size_t)qrow * DM + head * 128 + v,
                    make_float4(O[vi][4 * ig] * rs * g4.x, O[vi][4 * ig + 1] * rs * g4.y, O[vi][4 * ig + 2] * rs * g4.z, O[vi][4 * ig + 3] * rs * g4.w));
        }
    }
    __syncthreads();
  }
}

DI void phase_final(const Params& p) {
  const float* xr = (const float*)(wsp(p) + OFF_XR);
  const int lane = tidx() & 63, wid = tidx() >> 6;
  for (int row = (blockIdx.x * 4 + wid) * 2; row < T_LAT; row += gridDim.x * 8) {
    float va[16], vb[16];
    norm_load(xr + (size_t)row * DM, lane, va);
    norm_load(xr + (size_t)(row + 1) * DM, lane, vb);
    norm_finish(p.in[I_FING], nullptr, nullptr, lane, va);
    norm_finish(p.in[I_FING], nullptr, nullptr, lane, vb);
#pragma unroll
    for (int j = 0; j < 4; ++j) {
      *(float4*)(p.out + (size_t)row * DM + 4 * lane + 256 * j) = make_float4(va[4 * j], va[4 * j + 1], va[4 * j + 2], va[4 * j + 3]);
      *(float4*)(p.out + (size_t)(row + 1) * DM + 4 * lane + 256 * j) = make_float4(vb[4 * j], vb[4 * j + 1], vb[4 * j + 2], vb[4 * j + 3]);
    }
  }
}

constexpr size_t FA_HB = 0, FA_VG = 33;
DI void run_ffn(const Params& p, int layer, int sub, unsigned char* smem) {
  const int rt = (layer == 3) ? 128 : 132;
  const bf16_t* wb = (const bf16_t*)(wsp(p) + OFF_WB);
  if (sub == 0) phase_norm(p, layer, 1, (bf16_t*)actp(p, FA_HB), rt * 128);
  else if (sub == 1) phase_ffn_in(p, smem, (const bf16_t*)actp(p, FA_HB), (bf16_t*)actp(p, FA_VG), rt);
  else if (sub == 2) phase_ffn_act(p, layer, (bf16_t*)actp(p, FA_VG), rt * 128);
  else phase_gemm_resid(p, smem, layer, (const bf16_t*)actp(p, FA_VG), 5632, 2816, wb + W_FOUT, 5, rt);
}
DI void run_phase(const Params& p, int ph, unsigned char* smem, int rep = 0) {
  const bf16_t* wb = (const bf16_t*)(wsp(p) + OFF_WB);
  if (ph == 0) { phase0(p, smem); return; }
  if (ph == NPH - 1) { phase_final(p); return; }
  int layer, sub;
  if (ph < 12) { layer = 0; sub = ph - 1; } else if (ph < 23) { layer = 1; sub = ph - 12; } else if (ph < 31) { layer = 2; sub = ph - 23; } else { layer = 3; sub = ph - 31; }
  const int kind = layer % 3, j = layer / 3;
  if (kind == 0) {
    if (sub == 0) { convert_weights(p, layer, smem, 2, 99); phase_norm_shift(p, layer, (bf16_t*)actp(p, RA_HB), (bf16_t*)actp(p, RA_XX), p.in[I_RMIX] + (size_t)j * 6 * 1024, (bf16_t*)actp(p, 165), (bf16_t*)actp(p, 198), (bf16_t*)actp(p, 231)); }
    else if (sub == 1) phase_rwkv_proj1(p, j, smem);
    else if (sub == 2) phase_rwkv_proj2(p, j, smem);
    else if (sub == 3) phase_rwkv_scan(p, j, smem, j + 2 * rep);
    else if (sub == 4) phase_rwkv_post(p, j, layer == 3 ? T_LAT : T_ALL);
    else if (sub == 5) phase_rwkv_gate(p, smem, layer == 3 ? 128 : 132);
    else if (sub == 6) phase_gemm_resid(p, smem, layer, (const bf16_t*)actp(p, RA_ZB), 1024, 1024, wb + RW_OUT, 2, layer == 3 ? 128 : 132);
    else run_ffn(p, layer, sub - 7, smem);
  } else if (kind == 1) {
    if (sub == 0) { convert_weights(p, layer, smem); phase_norm(p, layer, 0, (bf16_t*)actp(p, MA_HB)); }
    else if (sub == 1) phase_ml_in(p, j, smem);
    else if (sub == 2) phase_ml_cloc(p, smem);
    else if (sub == 3) phase_ml_cscan(p);
    else if (sub == 4) phase_ml_out(p, smem);
    else if (sub == 5) phase_ml_post(p, j);
    else if (sub == 6) phase_gemm_resid(p, smem, layer, (const bf16_t*)actp(p, MA_ZB), 1024, 1024, wb + ML_WO, 2);
    else run_ffn(p, layer, sub - 7, smem);
  } else {
    if (sub == 0) { convert_weights(p, layer, smem); phase_norm(p, layer, 0, (bf16_t*)actp(p, DA_HB)); }
    else if (sub == 1) phase_da_qkv(p, smem);
    else if (sub == 2) phase_da_attn(p, j, smem);
    else if (sub == 3) phase_gemm_resid(p, smem, layer, (const bf16_t*)actp(p, DA_OB), 1024, 1024, wb + DA_WO, 2);
    else run_ffn(p, layer, sub - 4, smem);
  }
}


#define XB_TMO      128
#define XB_XCNT(j)  (256  + 64 * (j))
#define XB_XSUB(j)  (1280 + 64 * (j))
#define XB_XGEN(j)  (2304 + 64 * (j))
#define XB_TOP      3328
#define XB_TOPGEN   3392
#define XCD_BAR_WORDS 3456
#define XB_SPIN_CAP (1u << 20)
#define LAS __attribute__((address_space(3)))
constexpr size_t MISC_BAR = 768 * 1024;
DI unsigned xb_ld(unsigned* p)              { return __hip_atomic_load(p, __ATOMIC_RELAXED, __HIP_MEMORY_SCOPE_AGENT); }
DI unsigned xb_add(unsigned* p, unsigned v) { return __hip_atomic_fetch_add(p, v, __ATOMIC_RELAXED, __HIP_MEMORY_SCOPE_AGENT); }
DI unsigned xb_xcc_id() { return (unsigned)__builtin_amdgcn_s_getreg((3 << 11) | 20) & 0xFu; }
#define XB_SPIN(cond, bar) do { unsigned _sp = 0; while (cond) { __builtin_amdgcn_s_sleep(1); \
    if ((++_sp & 255u) == 0u) { if (xb_ld(&(bar)[XB_TMO])) break; if (_sp > XB_SPIN_CAP) { atomicAdd(&(bar)[XB_TMO], 1u); break; } } } } while (0)
struct XcdBarrier { unsigned* bar; unsigned x; volatile LAS unsigned* st; };
DI XcdBarrier xcd_barrier_post(unsigned* bar, volatile LAS unsigned* st) {
  XcdBarrier b; b.bar = bar; b.x = xb_xcc_id(); b.st = st;
  if (threadIdx.x == 0) (void)xb_add(&bar[XB_XCNT(b.x)], 1u);
  return b;
}
DI void xcd_barrier_complete(unsigned* bar, unsigned x, unsigned& nloc, unsigned& nx) {
  const unsigned G = gridDim.x * gridDim.y * gridDim.z;
  unsigned sum, cnt, mine, sp = 0u;
  for (;;) {
    sum = 0u; cnt = 0u; mine = 0u;
#pragma unroll
    for (unsigned j = 0; j < 16; ++j) { const unsigned c = xb_ld(&bar[XB_XCNT(j)]); sum += c; cnt += (c > 0u) ? 1u : 0u; mine = (j == x) ? c : mine; }
    if (sum == G) break;
    __builtin_amdgcn_s_sleep(1);
    if ((++sp & 255u) == 0u) { if (xb_ld(&bar[XB_TMO])) break; if (sp > XB_SPIN_CAP) { atomicAdd(&bar[XB_TMO], 1u); break; } }
  }
  nloc = mine > 0u ? mine : 1u; nx = cnt > 0u ? cnt : 1u;
}
DI void xcd_barrier(const XcdBarrier& b) {
  asm volatile("s_waitcnt vmcnt(0)" ::: "memory");
  __syncthreads();
  if (threadIdx.x == 0) {
    unsigned* bar = b.bar;
    __builtin_amdgcn_s_waitcnt(0);
    unsigned nloc = b.st[0], nx = b.st[1];
    if (nloc == 0u) { xcd_barrier_complete(bar, b.x, nloc, nx); b.st[0] = nloc; b.st[1] = nx; }
    const unsigned old = xb_add(&bar[XB_XSUB(b.x)], 1u);
    const unsigned gen = old / nloc;
    if (old + 1u == (gen + 1u) * nloc) {
      __builtin_amdgcn_fence(__ATOMIC_RELEASE, "agent");
      asm volatile("s_waitcnt vmcnt(0)" ::: "memory");
      const unsigned og = xb_add(&bar[XB_TOP], 1u);
      const unsigned tg = og / nx;
      if (og + 1u == (tg + 1u) * nx) xb_add(&bar[XB_TOPGEN], 1u);
      else XB_SPIN(xb_ld(&bar[XB_TOPGEN]) == tg, bar);
      __builtin_amdgcn_fence(__ATOMIC_ACQUIRE, "agent");
      xb_add(&bar[XB_XGEN(b.x)], 1u);
      asm volatile("s_waitcnt vmcnt(0)" ::: "memory");
    } else {
      XB_SPIN(xb_ld(&bar[XB_XGEN(b.x)]) == gen, bar);
      __builtin_amdgcn_fence(__ATOMIC_ACQUIRE, "agent");
      asm volatile("s_waitcnt vmcnt(0)" ::: "memory");
    }
  }
  __syncthreads();
}

__global__ void __launch_bounds__(256, 2) mega(Params p) {
  __shared__ __attribute__((aligned(16))) unsigned char smem[SMEM_BYTES];
  __shared__ uint4 xb_words;
  cg::grid_group grid = cg::this_grid();
  if (threadIdx.x == 0) xb_words = make_uint4(0u, 0u, 0u, 0u);
  __syncthreads();
  const XcdBarrier xb = xcd_barrier_post((unsigned*)(p.ws + OFF_MISC + MISC_BAR), (volatile LAS unsigned*)&xb_words);
  for (int ph = p.ph_lo; ph < p.ph_hi; ++ph) {
    run_phase(p, ph, smem);
    if (ph + 1 < p.ph_hi) { if (ph == p.ph_lo) grid.sync(); else xcd_barrier(xb); }
  }
}

extern "C" void kernel_launch(void* const* d_in, const int* in_sizes, int n_in, void* d_out, int out_size, void* d_ws, size_t ws_size, hipStream_t stream) {
  static int grid_blocks = 0;
  if (!grid_blocks) {
    int dev = 0, cus = 0, per_cu = 0;
    (void)hipGetDevice(&dev);
    (void)hipDeviceGetAttribute(&cus, hipDeviceAttributeMultiprocessorCount, dev);
    (void)hipOccupancyMaxActiveBlocksPerMultiprocessor(&per_cu, mega, 256, 0);
    if (per_cu < 1) per_cu = 1;
    if (per_cu > 2) per_cu = 2;
    grid_blocks = cus * per_cu;
  }
  if (ws_size < (size_t)358 * MiB || out_size < 16384 * 1024) { fprintf(stderr, "workspace too small: %zu\n", ws_size); return; }
  Params p;
  memset(&p, 0, sizeof(p));
  for (int i = 0; i < 37; ++i) p.in[i] = (const float*)d_in[i];
  p.out = (float*)d_out;
  p.ws = (unsigned char*)d_ws;
  p.ph_lo = 0; p.ph_hi = NPH;
  (void)hipMemsetAsync((unsigned char*)d_ws + OFF_MISC + MISC_BAR, 0, XCD_BAR_WORDS * 4, stream);
  void* args[] = {&p};
  hipError_t e = hipLaunchCooperativeKernel((void*)mega, dim3(grid_blocks), dim3(256), args, 0, stream);
  if (e != hipSuccess) fprintf(stderr, "cooperative launch failed: %s (grid %d)\n", hipGetErrorString(e), grid_blocks);
}
```

```cpp
#include <hip/hip_runtime.h>
#include <hip/hip_cooperative_groups.h>
#include <cstdio>
#include <cstdint>
#include <cstring>
namespace cg = cooperative_groups;

#define DI __device__ __forceinline__
#define XCD_FOR(t, n) for (int per_ = ((n) + 7) >> 3, i_ = blockIdx.x >> 3, t = (int)(blockIdx.x & 7) * per_ + i_; i_ < per_ && t < (n); i_ += (int)(gridDim.x >> 3), t += (int)(gridDim.x >> 3))
typedef unsigned short bf16_t;
typedef _Float16 f16_t;
typedef short bf16x8 __attribute__((ext_vector_type(8)));
typedef float f32x16 __attribute__((ext_vector_type(16)));
typedef float f32x4 __attribute__((ext_vector_type(4)));
typedef _Float16 f16x4 __attribute__((ext_vector_type(4)));

constexpr int T_ALL = 16896, T_LAT = 16384, DM = 1024, FF = 2816;
constexpr size_t MiB = 1ull << 20;
constexpr size_t OFF_XR = 0, OFF_WB = 66 * MiB, OFF_MISC = 93 * MiB, OFF_ACT = 94 * MiB;
constexpr int SMEM_BYTES = 73728;
constexpr size_t MISC_CNT = 512 * 1024;
constexpr int NPH = 43;

constexpr size_t W_FIN = 0, W_FOUT = 5632ull * 1024, W_MIX = W_FOUT + 1024ull * 2816;
constexpr size_t M1 = 1048576;
constexpr size_t RW_RKV = W_MIX, RW_OUT = W_MIX + 3 * M1, RW_W1C = W_MIX + 4 * M1, RW_A1C = RW_W1C + 131072, RW_G1 = RW_W1C + 262144,
                 RW_W2 = RW_W1C + 524288, RW_A2 = RW_W1C + 655360, RW_G2 = RW_W1C + 786432;
constexpr size_t ML_WIN = W_MIX, ML_WG = W_MIX + 3 * M1, ML_WO = ML_WG + 131072;
constexpr size_t DA_QKV = W_MIX, DA_WO = W_MIX + 3 * M1;

struct Params {
  const float* in[37];
  float* out;
  unsigned char* ws;
  int ph_lo, ph_hi;
};
DI int tidx() { int t = threadIdx.x; asm volatile("" : "+v"(t)); return t; }
DI unsigned char* wsp(const Params& p) { size_t z = 0; asm volatile("" : "+s"(z)); return p.ws + z; }
enum { I_X = 0, I_C, I_CTX, I_CCTX, I_ADAW, I_ADAB, I_N1G, I_N2G, I_FWIN, I_FCW, I_FCB, I_FWOUT, I_RMIX, I_RWRKV, I_RW0, I_RW1, I_RW2, I_RA0, I_RA1,
       I_RA2, I_RG1, I_RG2, I_RKK, I_RKA, I_RRK, I_RLNG, I_RLNB, I_RWOUT, I_MWIN, I_MBIN, I_MNG, I_MWOUT, I_DQKV, I_DLAM, I_DNG, I_DWOUT, I_FING };

DI unsigned f2bf(float f) { unsigned u = __float_as_uint(f); return (u + 0x7fffu + ((u >> 16) & 1u)) >> 16; }
DI float bf2f(unsigned b) { return __uint_as_float(b << 16); }
typedef __bf16 hbf16x2 __attribute__((ext_vector_type(2)));
typedef float hf32x2 __attribute__((ext_vector_type(2)));
DI unsigned pk2(float lo, float hi) { hf32x2 v = {lo, hi}; hbf16x2 b = __builtin_convertvector(v, hbf16x2); return __builtin_bit_cast(unsigned, b); }
DI float bflo(unsigned u) { return __uint_as_float(u << 16); }
DI float bfhi(unsigned u) { return __uint_as_float(u & 0xffff0000u); }
template <int CTRL> DI float dpp_f0(float v) { return __int_as_float(__builtin_amdgcn_update_dpp(0, __float_as_int(v), CTRL, 0xF, 0xF, true)); }
DI float wave_sum(float v) {
  v += dpp_f0<0xB1>(v); v += dpp_f0<0x4E>(v); v += dpp_f0<0x141>(v); v += dpp_f0<0x140>(v);
  v += __shfl_xor(v, 16);
  v += __shfl_xor(v, 32);
  return v;
}
template <int CTRL> DI float dpp_f(float v) { return __int_as_float(__builtin_amdgcn_update_dpp(0, __float_as_int(v), CTRL, 0xF, 0xF, true)); }
DI float allreduce16(float v) {
  v += dpp_f<0xB1>(v);
  v += dpp_f<0x4E>(v);
  v += dpp_f<0x141>(v);
  v += dpp_f<0x140>(v);
  return v;
}
DI float tanh_fast(float x) { return 1.f - 2.f * __builtin_amdgcn_rcpf(1.f + __expf(2.f * x)); }
DI float sigmoidf_(float x) { return __builtin_amdgcn_rcpf(1.f + __expf(-x)); }
DI int modset_of(int row) { return row < T_LAT ? (row >> 13) : 2; }
DI f32x16 mfma32(bf16x8 a, bf16x8 b, f32x16 c) { return __builtin_amdgcn_mfma_f32_32x32x16_bf16(a, b, c, 0, 0, 0); }
DI bf16x8 pack8(const f32x16& x, int s) {
  uint4 u;
  if (s == 0) { u.x = pk2(x[0], x[1]); u.y = pk2(x[2], x[3]); u.z = pk2(x[4], x[5]); u.w = pk2(x[6], x[7]); }
  else { u.x = pk2(x[8], x[9]); u.y = pk2(x[10], x[11]); u.z = pk2(x[12], x[13]); u.w = pk2(x[14], x[15]); }
  return __builtin_bit_cast(bf16x8, u);
}
DI int perm16(int w) { return 8 * ((w >> 2) & 1) + 4 * (w >> 3) + (w & 3); }

DI int swz_tm(int t, int tilesN) { const int per_g = 8 * tilesN, g = t / per_g, idx = t - g * per_g, rows = (132 - 8 * g) < 8 ? (132 - 8 * g) : 8; return 8 * g + idx % rows; }
DI int swz_tn(int t, int tilesN) { const int per_g = 8 * tilesN, g = t / per_g, idx = t - g * per_g, rows = (132 - 8 * g) < 8 ? (132 - 8 * g) : 8; return idx / rows; }
constexpr int G_ROWB = 144, G_OPB = 128 * G_ROWB, G_STAGE = 2 * G_OPB;

template <class Epi>
DI void gemm_epilogue(unsigned char* lds, f32x16 (&acc)[2][2], int tm, int tn, const Epi& epi) {
  const int tid = tidx(), lane = tid & 63, wid = tid >> 6;
  const int wm = wid & 1, wn = wid >> 1, r32 = lane & 31, hh = lane >> 5;
  const int m0 = tm * 128, n0 = tn * 128;
  if constexpr (Epi::kBatch == 2) {
    const bool tr = epi.trans(n0);
#pragma unroll
    for (int mi = 0; mi < 2; ++mi) {
      const int rl = 64 * wm + 32 * mi + r32;
#pragma unroll
      for (int ig = 0; ig < 4; ++ig) {
        const int cl = 64 * wn + 8 * ig + 4 * hh;
        float4 lo = make_float4(acc[0][mi][4 * ig], acc[0][mi][4 * ig + 1], acc[0][mi][4 * ig + 2], acc[0][mi][4 * ig + 3]);
        float4 hi = make_float4(acc[1][mi][4 * ig], acc[1][mi][4 * ig + 1], acc[1][mi][4 * ig + 2], acc[1][mi][4 * ig + 3]);
        epi.xf(m0 + rl, n0 + cl, lo, hi);
        uint2 ulo, uhi;
        if (Epi::kF16) {
          f16x4 a, b; a[0] = (f16_t)lo.x; a[1] = (f16_t)lo.y; a[2] = (f16_t)lo.z; a[3] = (f16_t)lo.w; b[0] = (f16_t)hi.x; b[1] = (f16_t)hi.y; b[2] = (f16_t)hi.z; b[3] = (f16_t)hi.w;
          ulo = __builtin_bit_cast(uint2, a); uhi = __builtin_bit_cast(uint2, b);
        } else { ulo.x = pk2(lo.x, lo.y); ulo.y = pk2(lo.z, lo.w); uhi.x = pk2(hi.x, hi.y); uhi.y = pk2(hi.z, hi.w); }
        if (!tr) {
          *(uint2*)(lds + rl * 272 + cl * 2) = ulo;
          *(uint2*)(lds + rl * 272 + (cl + 32) * 2) = uhi;
        } else {
          const int rp = ((rl & ~15) | perm16(rl & 15)) * 2;
          unsigned short* q0 = (unsigned short*)(lds + cl * 272 + rp); unsigned short* q1 = (unsigned short*)(lds + (cl + 32) * 272 + rp);
          q0[0] = (unsigned short)(ulo.x & 0xffff); q0[136] = (unsigned short)(ulo.x >> 16); q0[272] = (unsigned short)(ulo.y & 0xffff); q0[408] = (unsigned short)(ulo.y >> 16);
          q1[0] = (unsigned short)(uhi.x & 0xffff); q1[136] = (unsigned short)(uhi.x >> 16); q1[272] = (unsigned short)(uhi.y & 0xffff); q1[408] = (unsigned short)(uhi.y >> 16);
        }
      }
    }
    __syncthreads();
    const int nch = epi.valid16(n0);
#pragma unroll
    for (int i = 0; i < 8; ++i) {
      const int c = tid + 256 * i, row = c >> 4, cc = c & 15;
      if (cc < nch) {
        uint4 v = *(const uint4*)(lds + row * 272 + cc * 16);
        v = epi.post(m0, n0, row, cc, v);
        *(uint4*)(epi.rowptr(m0, n0, row) + cc * 8) = v;
      }
    }
    __syncthreads();
  } else if constexpr (Epi::kBatch == 3) {
#pragma unroll
    for (int mi = 0; mi < 2; ++mi) {
      const int rl = 64 * wm + 32 * mi + r32;
#pragma unroll
      for (int ig = 0; ig < 4; ++ig) {
        const int cl = 64 * wn + 8 * ig + 4 * hh;
        *(float4*)(lds + rl * 528 + cl * 4) = make_float4(acc[0][mi][4 * ig], acc[0][mi][4 * ig + 1], acc[0][mi][4 * ig + 2], acc[0][mi][4 * ig + 3]);
        *(float4*)(lds + rl * 528 + (cl + 32) * 4) = make_float4(acc[1][mi][4 * ig], acc[1][mi][4 * ig + 1], acc[1][mi][4 * ig + 2], acc[1][mi][4 * ig + 3]);
      }
    }
    __syncthreads();
#pragma unroll
    for (int h2 = 0; h2 < 2; ++h2) {
      float4 x[8], g[8];
#pragma unroll
      for (int i = 0; i < 8; ++i) {
        const int c = tid + 256 * (8 * h2 + i), row = c >> 5, cc = c & 31, m = m0 + row;
        x[i] = *(const float4*)(epi.xr + (size_t)m * DM + n0 + cc * 4);
        g[i] = *(const float4*)(epi.gate + modset_of(m) * 6144 + n0 + cc * 4);
      }
#pragma unroll
      for (int i = 0; i < 8; ++i) {
        const int c = tid + 256 * (8 * h2 + i), row = c >> 5, cc = c & 31, m = m0 + row;
        const float4 a = *(const float4*)(lds + row * 528 + cc * 16);
        float4 o = x[i];
        o.x += g[i].x * a.x; o.y += g[i].y * a.y; o.z += g[i].z * a.z; o.w += g[i].w * a.w;
        *(float4*)(epi.xr + (size_t)m * DM + n0 + cc * 4) = o;
      }
    }
    __syncthreads();
  } else {
#pragma unroll
    for (int mi = 0; mi < 2; ++mi) {
      const int m = m0 + 64 * wm + 32 * mi + r32;
#pragma unroll
      for (int ig = 0; ig < 4; ++ig) {
        const int n = n0 + 64 * wn + 8 * ig + 4 * hh;
        float4 lo = make_float4(acc[0][mi][4 * ig], acc[0][mi][4 * ig + 1], acc[0][mi][4 * ig + 2], acc[0][mi][4 * ig + 3]);
        float4 hi = make_float4(acc[1][mi][4 * ig], acc[1][mi][4 * ig + 1], acc[1][mi][4 * ig + 2], acc[1][mi][4 * ig + 3]);
        epi(m, n, lo, hi);
      }
    }
  }
}

template <class Epi>
DI void gemm_tile_p2(unsigned char* lds, const bf16_t* __restrict__ A, int lda, const bf16_t* __restrict__ Bt, int ldb, int K, int tm, int tn, const Epi& epi) {
  const int tid = tidx(), lane = tid & 63, wid = tid >> 6;
  const int wm = wid & 1, wn = wid >> 1, r32 = lane & 31, hh = lane >> 5;
  const int lrow = tid >> 3, kc = tid & 7;
  const int m0 = tm * 128, n0 = tn * 128, nt = K >> 6;
  f32x16 acc[2][2];
#pragma unroll
  for (int a = 0; a < 2; ++a)
#pragma unroll
    for (int b = 0; b < 2; ++b)
#pragma unroll
      for (int i = 0; i < 16; ++i) acc[a][b][i] = 0.f;
  uint4 pa0, pa1, pa2, pa3, pb0, pb1, pb2, pb3, qa0, qa1, qa2, qa3, qb0, qb1, qb2, qb3;
  const bf16_t* Ap = A + (size_t)(m0 + lrow) * lda + kc * 8;
  const bf16_t* Bp = Bt + (size_t)(n0 + lrow) * ldb + kc * 8;
  const size_t a32 = (size_t)32 * lda, b32 = (size_t)32 * ldb;
#define P2_GLOAD(kt_, S) do { const int ko_ = (kt_) * 64; \
    S##a0 = *(const uint4*)(Ap + ko_); S##a1 = *(const uint4*)(Ap + a32 + ko_); S##a2 = *(const uint4*)(Ap + 2 * a32 + ko_); S##a3 = *(const uint4*)(Ap + 3 * a32 + ko_); \
    S##b0 = *(const uint4*)(Bp + ko_); S##b1 = *(const uint4*)(Bp + b32 + ko_); S##b2 = *(const uint4*)(Bp + 2 * b32 + ko_); S##b3 = *(const uint4*)(Bp + 3 * b32 + ko_); } while (0)
#define P2_LWRITE(buf_, S) do { unsigned char* base_ = lds + (buf_) * G_STAGE + lrow * G_ROWB + kc * 16; \
    *(uint4*)(base_) = S##a0; *(uint4*)(base_ + 32 * G_ROWB) = S##a1; *(uint4*)(base_ + 64 * G_ROWB) = S##a2; *(uint4*)(base_ + 96 * G_ROWB) = S##a3; \
    *(uint4*)(base_ + G_OPB) = S##b0; *(uint4*)(base_ + G_OPB + 32 * G_ROWB) = S##b1; *(uint4*)(base_ + G_OPB + 64 * G_ROWB) = S##b2; *(uint4*)(base_ + G_OPB + 96 * G_ROWB) = S##b3; } while (0)
#define P2_LDF(ks_, S) do { S##a0 = *(const bf16x8*)(bA + (ks_) * 32); S##a1 = *(const bf16x8*)(bA + 32 * G_ROWB + (ks_) * 32); \
    S##b0 = *(const bf16x8*)(bB + (ks_) * 32); S##b1 = *(const bf16x8*)(bB + 32 * G_ROWB + (ks_) * 32); } while (0)
#define P2_MMA(S) do { acc[0][0] = mfma32(S##b0, S##a0, acc[0][0]); acc[0][1] = mfma32(S##b0, S##a1, acc[0][1]); \
    acc[1][0] = mfma32(S##b1, S##a0, acc[1][0]); acc[1][1] = mfma32(S##b1, S##a1, acc[1][1]); } while (0)
#define P2_COMPUTE(buf_) do { \
    const unsigned char* bA = lds + (buf_) * G_STAGE + (64 * wm + r32) * G_ROWB + hh * 16; \
    const unsigned char* bB = lds + (buf_) * G_STAGE + G_OPB + (64 * wn + r32) * G_ROWB + hh * 16; \
    bf16x8 fxa0, fxa1, fxb0, fxb1, fya0, fya1, fyb0, fyb1; \
    P2_LDF(0, fx); P2_LDF(1, fy); __builtin_amdgcn_sched_barrier(0); \
    P2_MMA(fx); __builtin_amdgcn_sched_barrier(0); P2_LDF(2, fx); __builtin_amdgcn_sched_barrier(0); \
    P2_MMA(fy); __builtin_amdgcn_sched_barrier(0); P2_LDF(3, fy); __builtin_amdgcn_sched_barrier(0); \
    P2_MMA(fx); P2_MMA(fy); __builtin_amdgcn_sched_barrier(0); } while (0)
  P2_GLOAD(0, p);
  P2_GLOAD(1, q);
  P2_LWRITE(0, p);
  __syncthreads();
#pragma unroll 1
  for (int kt = 0; kt < nt; kt += 2) {
    { const int k2 = (kt + 2 < nt) ? kt + 2 : nt - 1; P2_GLOAD(k2, p); }
    P2_COMPUTE(0);
    P2_LWRITE(1, q);
    __syncthreads();
    { const int k3 = (kt + 3 < nt) ? kt + 3 : nt - 1; P2_GLOAD(k3, q); }
    P2_COMPUTE(1);
    P2_LWRITE(0, p);
    __syncthreads();
  }
  gemm_epilogue(lds, acc, tm, tn, epi);
}


template <class Epi>
DI void gemm_tile_big(unsigned char* lds, const bf16_t* __restrict__ A, int lda, const bf16_t* __restrict__ Bt, int ldb, int K, int tm, int tn, const Epi& epi) {
  const int tid = tidx(), lane = tid & 63, wid = tid >> 6;
  const int wm = wid & 1, wn = wid >> 1, r32 = lane & 31, hh = lane >> 5;
  const int lrow = tid >> 3, kc = tid & 7;
  const int m0 = tm * 256, n0 = tn * 128, nt = K >> 6;
  constexpr int BOFF = 256 * G_ROWB;
  f32x16 acc[2][4];
#pragma unroll
  for (int a = 0; a < 2; ++a)
#pragma unroll
    for (int b = 0; b < 4; ++b)
#pragma unroll
      for (int i = 0; i < 16; ++i) acc[a][b][i] = 0.f;
  uint4 a0, a1, a2, a3, a4, a5, a6, a7, b0, b1, b2, b3;
  const bf16_t* Ap = A + (size_t)(m0 + lrow) * lda + kc * 8;
  const bf16_t* Bp = Bt + (size_t)(n0 + lrow) * ldb + kc * 8;
  const size_t a32 = (size_t)32 * lda, b32 = (size_t)32 * ldb;
#define B_GLOAD(kt_) do { const int ko_ = (kt_) * 64; \
    a0 = *(const uint4*)(Ap + ko_); a1 = *(const uint4*)(Ap + a32 + ko_); a2 = *(const uint4*)(Ap + 2 * a32 + ko_); a3 = *(const uint4*)(Ap + 3 * a32 + ko_); \
    a4 = *(const uint4*)(Ap + 4 * a32 + ko_); a5 = *(const uint4*)(Ap + 5 * a32 + ko_); a6 = *(const uint4*)(Ap + 6 * a32 + ko_); a7 = *(const uint4*)(Ap + 7 * a32 + ko_); \
    b0 = *(const uint4*)(Bp + ko_); b1 = *(const uint4*)(Bp + b32 + ko_); b2 = *(const uint4*)(Bp + 2 * b32 + ko_); b3 = *(const uint4*)(Bp + 3 * b32 + ko_); } while (0)
#define B_LWRITE() do { unsigned char* base_ = lds + lrow * G_ROWB + kc * 16; \
    *(uint4*)(base_) = a0; *(uint4*)(base_ + 32 * G_ROWB) = a1; *(uint4*)(base_ + 64 * G_ROWB) = a2; *(uint4*)(base_ + 96 * G_ROWB) = a3; \
    *(uint4*)(base_ + 128 * G_ROWB) = a4; *(uint4*)(base_ + 160 * G_ROWB) = a5; *(uint4*)(base_ + 192 * G_ROWB) = a6; *(uint4*)(base_ + 224 * G_ROWB) = a7; \
    *(uint4*)(base_ + BOFF) = b0; *(uint4*)(base_ + BOFF + 32 * G_ROWB) = b1; *(uint4*)(base_ + BOFF + 64 * G_ROWB) = b2; *(uint4*)(base_ + BOFF + 96 * G_ROWB) = b3; } while (0)
  B_GLOAD(0);
  B_LWRITE();
  __syncthreads();
  const unsigned char* bA = lds + (128 * wm + r32) * G_ROWB + hh * 16;
  const unsigned char* bB = lds + BOFF + (64 * wn + r32) * G_ROWB + hh * 16;
#define B_COMPUTE() do { \
    _Pragma("unroll") for (int ks = 0; ks < 4; ++ks) { \
      const bf16x8 f0 = *(const bf16x8*)(bB + ks * 32), f1 = *(const bf16x8*)(bB + 32 * G_ROWB + ks * 32); \
      _Pragma("unroll") for (int mi = 0; mi < 4; ++mi) { \
        const bf16x8 af = *(const bf16x8*)(bA + mi * 32 * G_ROWB + ks * 32); \
        acc[0][mi] = mfma32(f0, af, acc[0][mi]); acc[1][mi] = mfma32(f1, af, acc[1][mi]); } } } while (0)
#pragma unroll 1
  for (int kt = 0; kt + 1 < nt; ++kt) {
    B_GLOAD(kt + 1);
    B_COMPUTE();
    __syncthreads();
    B_LWRITE();
    __syncthreads();
  }
  B_COMPUTE();
  __syncthreads();
  if constexpr (Epi::kBatch == 2) {
    const bool tr = epi.trans(n0);
#pragma unroll
    for (int mi = 0; mi < 4; ++mi) {
      const int rl = 128 * wm + 32 * mi + r32;
#pragma unroll
      for (int ig = 0; ig < 4; ++ig) {
        const int cl = 64 * wn + 8 * ig + 4 * hh;
        float4 lo = make_float4(acc[0][mi][4 * ig], acc[0][mi][4 * ig + 1], acc[0][mi][4 * ig + 2], acc[0][mi][4 * ig + 3]);
        float4 hi = make_float4(acc[1][mi][4 * ig], acc[1][mi][4 * ig + 1], acc[1][mi][4 * ig + 2], acc[1][mi][4 * ig + 3]);
        epi.xf(m0 + rl, n0 + cl, lo, hi);
        uint2 ulo, uhi;
        if (Epi::kF16) {
          f16x4 a, b; a[0] = (f16_t)lo.x; a[1] = (f16_t)lo.y; a[2] = (f16_t)lo.z; a[3] = (f16_t)lo.w; b[0] = (f16_t)hi.x; b[1] = (f16_t)hi.y; b[2] = (f16_t)hi.z; b[3] = (f16_t)hi.w;
          ulo = __builtin_bit_cast(uint2, a); uhi = __builtin_bit_cast(uint2, b);
        } else { ulo.x = pk2(lo.x, lo.y); ulo.y = pk2(lo.z, lo.w); uhi.x = pk2(hi.x, hi.y); uhi.y = pk2(hi.z, hi.w); }
        if (!tr) {
          *(uint2*)(lds + rl * 272 + cl * 2) = ulo;
          *(uint2*)(lds + rl * 272 + (cl + 32) * 2) = uhi;
        } else {
          const int rp = ((rl & ~15) | perm16(rl & 15)) * 2;
          unsigned short* q0 = (unsigned short*)(lds + cl * 528 + rp); unsigned short* q1 = (unsigned short*)(lds + (cl + 32) * 528 + rp);
          q0[0] = (unsigned short)(ulo.x & 0xffff); q0[264] = (unsigned short)(ulo.x >> 16); q0[528] = (unsigned short)(ulo.y & 0xffff); q0[792] = (unsigned short)(ulo.y >> 16);
          q1[0] = (unsigned short)(uhi.x & 0xffff); q1[264] = (unsigned short)(uhi.x >> 16); q1[528] = (unsigned short)(uhi.y & 0xffff); q1[792] = (unsigned short)(uhi.y >> 16);
        }
      }
    }
    __syncthreads();
    if (!tr) {
      const int nch = epi.valid16(n0);
#pragma unroll
      for (int i = 0; i < 16; ++i) {
        const int c = tid + 256 * i, row = c >> 4, cc = c & 15;
        if (cc < nch) {
          uint4 v = *(const uint4*)(lds + row * 272 + cc * 16);
          v = epi.post(m0, n0, row, cc, v);
          *(uint4*)(epi.rowptr(m0, n0, row) + cc * 8) = v;
        }
      }
    } else {
#pragma unroll
      for (int i = 0; i < 16; ++i) {
        const int c = tid + 256 * i, row = c >> 5, cc = c & 31;
        *(uint4*)(epi.rowptr(m0, n0, row) + cc * 8) = *(const uint4*)(lds + row * 528 + cc * 16);
      }
    }
    __syncthreads();
  } else {
#pragma unroll
    for (int hf = 0; hf < 2; ++hf) {
      if (wm == hf) {
#pragma unroll
        for (int mi = 0; mi < 4; ++mi) {
          const int rl = 32 * mi + r32;
#pragma unroll
          for (int ig = 0; ig < 4; ++ig) {
            const int cl = 64 * wn + 8 * ig + 4 * hh;
            *(float4*)(lds + rl * 528 + cl * 4) = make_float4(acc[0][mi][4 * ig], acc[0][mi][4 * ig + 1], acc[0][mi][4 * ig + 2], acc[0][mi][4 * ig + 3]);
            *(float4*)(lds + rl * 528 + (cl + 32) * 4) = make_float4(acc[1][mi][4 * ig], acc[1][mi][4 * ig + 1], acc[1][mi][4 * ig + 2], acc[1][mi][4 * ig + 3]);
          }
        }
      }
      __syncthreads();
#pragma unroll
      for (int h2 = 0; h2 < 2; ++h2) {
        float4 x[8], g[8];
#pragma unroll
        for (int i = 0; i < 8; ++i) {
          const int c = tid + 256 * (8 * h2 + i), row = c >> 5, cc = c & 31, m = m0 + 128 * hf + row;
          x[i] = *(const float4*)(epi.xr + (size_t)m * DM + n0 + cc * 4);
          g[i] = *(const float4*)(epi.gate + modset_of(m) * 6144 + n0 + cc * 4);
        }
#pragma unroll
        for (int i = 0; i < 8; ++i) {
          const int c = tid + 256 * (8 * h2 + i), row = c >> 5, cc = c & 31, m = m0 + 128 * hf + row;
          const float4 a = *(const float4*)(lds + row * 528 + cc * 16);
          float4 o = x[i];
          o.x += g[i].x * a.x; o.y += g[i].y * a.y; o.z += g[i].z * a.z; o.w += g[i].w * a.w;
          *(float4*)(epi.xr + (size_t)m * DM + n0 + cc * 4) = o;
        }
      }
      __syncthreads();
    }
  }
}

template <bool MIX, class Epi>
DI void gemm_tile(unsigned char* lds, const bf16_t* __restrict__ A, const bf16_t* __restrict__ A2, const float* __restrict__ mix, int lda,
                  const bf16_t* __restrict__ Bt, int ldb, int K, int tm, int tn, const Epi& epi) {
  if (!MIX && ((K >> 6) & 1) == 0) { gemm_tile_p2(lds, A, lda, Bt, ldb, K, tm, tn, epi); return; }
  const int tid = tidx(), lane = tid & 63, wid = tid >> 6;
  const int wm = wid & 1, wn = wid >> 1, r32 = lane & 31, hh = lane >> 5;
  const int lrow = tid >> 3, kc = tid & 7;
  const int m0 = tm * 128, n0 = tn * 128, nt = K >> 6;
  f32x16 acc[2][2];
#pragma unroll
  for (int a = 0; a < 2; ++a)
#pragma unroll
    for (int b = 0; b < 2; ++b)
#pragma unroll
      for (int i = 0; i < 16; ++i) acc[a][b][i] = 0.f;
  uint4 ra0, ra1, ra2, ra3, rb0, rb1, rb2, rb3, rx0, rx1, rx2, rx3;
  float4 mx0, mx1;
  rx0 = rx1 = rx2 = rx3 = make_uint4(0, 0, 0, 0); mx0 = mx1 = make_float4(0.f, 0.f, 0.f, 0.f);
  const bf16_t* Ap = A + (size_t)(m0 + lrow) * lda + kc * 8;
  const bf16_t* A2p = MIX ? (A2 + (size_t)(m0 + lrow) * lda + kc * 8) : nullptr;
  const bf16_t* Bp = Bt + (size_t)(n0 + lrow) * ldb + kc * 8;
  const size_t a32 = (size_t)32 * lda, b32 = (size_t)32 * ldb;
#define G_GLOAD(kt_) do { const int ko_ = (kt_) * 64; \
    ra0 = *(const uint4*)(Ap + ko_); ra1 = *(const uint4*)(Ap + a32 + ko_); ra2 = *(const uint4*)(Ap + 2 * a32 + ko_); ra3 = *(const uint4*)(Ap + 3 * a32 + ko_); \
    if (MIX) { rx0 = *(const uint4*)(A2p + ko_); rx1 = *(const uint4*)(A2p + a32 + ko_); rx2 = *(const uint4*)(A2p + 2 * a32 + ko_); rx3 = *(const uint4*)(A2p + 3 * a32 + ko_); \
               mx0 = *(const float4*)(mix + ko_ + kc * 8); mx1 = *(const float4*)(mix + ko_ + kc * 8 + 4); } \
    rb0 = *(const uint4*)(Bp + ko_); rb1 = *(const uint4*)(Bp + b32 + ko_); rb2 = *(const uint4*)(Bp + 2 * b32 + ko_); rb3 = *(const uint4*)(Bp + 3 * b32 + ko_); } while (0)
#define G_MIXV(v_, x_) do { if (MIX) { \
    v_.x = pk2(bflo(v_.x) + bflo(x_.x) * mx0.x, bfhi(v_.x) + bfhi(x_.x) * mx0.y); v_.y = pk2(bflo(v_.y) + bflo(x_.y) * mx0.z, bfhi(v_.y) + bfhi(x_.y) * mx0.w); \
    v_.z = pk2(bflo(v_.z) + bflo(x_.z) * mx1.x, bfhi(v_.z) + bfhi(x_.z) * mx1.y); v_.w = pk2(bflo(v_.w) + bflo(x_.w) * mx1.z, bfhi(v_.w) + bfhi(x_.w) * mx1.w); } } while (0)
#define G_LWRITE(buf_) do { unsigned char* base_ = lds + (buf_) * G_STAGE + lrow * G_ROWB + kc * 16; \
    G_MIXV(ra0, rx0); G_MIXV(ra1, rx1); G_MIXV(ra2, rx2); G_MIXV(ra3, rx3); \
    *(uint4*)(base_) = ra0; *(uint4*)(base_ + 32 * G_ROWB) = ra1; *(uint4*)(base_ + 64 * G_ROWB) = ra2; *(uint4*)(base_ + 96 * G_ROWB) = ra3; \
    *(uint4*)(base_ + G_OPB) = rb0; *(uint4*)(base_ + G_OPB + 32 * G_ROWB) = rb1; *(uint4*)(base_ + G_OPB + 64 * G_ROWB) = rb2; *(uint4*)(base_ + G_OPB + 96 * G_ROWB) = rb3; } while (0)
  G_GLOAD(0);
  G_LWRITE(0);
  __syncthreads();
#define G_COMPUTE(buf_) do { \
    const unsigned char* bA = lds + (buf_) * G_STAGE + (64 * wm + r32) * G_ROWB + hh * 16; \
    const unsigned char* bB = lds + (buf_) * G_STAGE + G_OPB + (64 * wn + r32) * G_ROWB + hh * 16; \
    _Pragma("unroll") for (int ks = 0; ks < 4; ++ks) { \
      const bf16x8 af0 = *(const bf16x8*)(bA + ks * 32), af1 = *(const bf16x8*)(bA + 32 * G_ROWB + ks * 32); \
      const bf16x8 bf0 = *(const bf16x8*)(bB + ks * 32), bf1 = *(const bf16x8*)(bB + 32 * G_ROWB + ks * 32); \
      acc[0][0] = mfma32(bf0, af0, acc[0][0]); acc[0][1] = mfma32(bf0, af1, acc[0][1]); \
      acc[1][0] = mfma32(bf1, af0, acc[1][0]); acc[1][1] = mfma32(bf1, af1, acc[1][1]); } } while (0)
#pragma unroll 1
  for (int kt = 0; kt + 1 < nt; ++kt) {
    G_GLOAD(kt + 1);
    G_COMPUTE(kt & 1);
    G_LWRITE((kt + 1) & 1);
    __syncthreads();
  }
  G_COMPUTE((nt - 1) & 1);
  __syncthreads();
  gemm_epilogue(lds, acc, tm, tn, epi);
}

DI void st_bf16x4(bf16_t* p, float4 v) { uint2 u; u.x = pk2(v.x, v.y); u.y = pk2(v.z, v.w); *(uint2*)p = u; }
DI void st_f16x4(f16_t* p, float4 v) { f16x4 h; h[0] = (f16_t)v.x; h[1] = (f16_t)v.y; h[2] = (f16_t)v.z; h[3] = (f16_t)v.w; *(f16x4*)p = h; }

struct EpiBf16 { static constexpr int kBatch = 2; static constexpr bool kF16 = false; bf16_t* C; int ldc; int nvalid; int act;
  DI float4 f(float4 v) const {
    if (act == 1) { v.x = tanh_fast(v.x); v.y = tanh_fast(v.y); v.z = tanh_fast(v.z); v.w = tanh_fast(v.w); }
    else if (act == 2) { v.x = sigmoidf_(v.x); v.y = sigmoidf_(v.y); v.z = sigmoidf_(v.z); v.w = sigmoidf_(v.w); }
    return v; }
  DI void xf(int, int, float4& lo, float4& hi) const { lo = f(lo); hi = f(hi); }
  DI bool trans(int) const { return false; }
  DI int valid16(int n0) const { const int r = (nvalid - n0) >> 3; return r > 16 ? 16 : r; }
  DI uint4 post(int, int, int, int, uint4 v) const { return v; }
  DI bf16_t* rowptr(int m0, int n0, int row) const { return C + (size_t)(m0 + row) * ldc + n0; }
  DI void operator()(int, int, float4, float4) const {} };
struct EpiNull { static constexpr int kBatch = 0; DI void operator()(int, int, float4, float4) const {} };
struct EpiF16 { static constexpr int kBatch = 2; static constexpr bool kF16 = true; f16_t* C;
  DI void xf(int, int, float4&, float4&) const {}
  DI bool trans(int) const { return false; }
  DI int valid16(int) const { return 16; }
  DI uint4 post(int, int, int, int, uint4 v) const { return v; }
  DI bf16_t* rowptr(int m0, int n0, int row) const { return (bf16_t*)C + (size_t)(m0 + row) * DM + n0; }
  DI void operator()(int, int, float4, float4) const {} };
struct EpiResid { static constexpr int kBatch = 3; float* xr; const float* gate;
  DI void operator()(int, int, float4, float4) const {} };
struct EpiDecay { static constexpr int kBatch = 2; static constexpr bool kF16 = true; f16_t* C; const float* bias; int mode;
  DI float4 one(int n, float4 v) const {
    const float4 b = *(const float4*)(bias + n); const float sc = mode == 0 ? 0.6065306597126334f : 1.f;
    v.x = sigmoidf_(v.x + b.x) * sc; v.y = sigmoidf_(v.y + b.y) * sc; v.z = sigmoidf_(v.z + b.z) * sc; v.w = sigmoidf_(v.w + b.w) * sc; return v; }
  DI void xf(int, int n, float4& lo, float4& hi) const { lo = one(n, lo); hi = one(n + 32, hi); }
  DI bool trans(int) const { return false; }
  DI int valid16(int) const { return 16; }
  DI uint4 post(int, int, int, int, uint4 v) const { return v; }
  DI bf16_t* rowptr(int m0, int n0, int row) const { return (bf16_t*)C + (size_t)(m0 + row) * DM + n0; }
  DI void operator()(int, int, float4, float4) const {} };
struct EpiMulZ { static constexpr int kBatch = 2; static constexpr bool kF16 = false; bf16_t* Z; const bf16_t* Z0;
  DI void xf(int, int, float4&, float4&) const {}
  DI bool trans(int) const { return false; }
  DI int valid16(int) const { return 16; }
  DI uint4 post(int m0, int n0, int row, int cc, uint4 v) const {
    const uint4 z = *(const uint4*)(Z0 + (size_t)(m0 + row) * DM + n0 + cc * 8);
    v.x = pk2(bflo(v.x) * bflo(z.x), bfhi(v.x) * bfhi(z.x)); v.y = pk2(bflo(v.y) * bflo(z.y), bfhi(v.y) * bfhi(z.y));
    v.z = pk2(bflo(v.z) * bflo(z.z), bfhi(v.z) * bfhi(z.z)); v.w = pk2(bflo(v.w) * bflo(z.w), bfhi(v.w) * bfhi(z.w)); return v; }
  DI bf16_t* rowptr(int m0, int n0, int row) const { return Z + (size_t)(m0 + row) * DM + n0; }
  DI void operator()(int, int, float4, float4) const {} };
struct EpiMlIn { static constexpr int kBatch = 2; static constexpr bool kF16 = false; bf16_t* C; int ldc; const float* bias; float scale; int act;
  DI float4 one(int n, float4 v) const {
    const float4 b = *(const float4*)(bias + n);
    v.x = (v.x + b.x) * scale; v.y = (v.y + b.y) * scale; v.z = (v.z + b.z) * scale; v.w = (v.w + b.w) * scale;
    if (act) { v.x = sigmoidf_(v.x); v.y = sigmoidf_(v.y); v.z = sigmoidf_(v.z); v.w = sigmoidf_(v.w); }
    return v; }
  DI void xf(int, int n, float4& lo, float4& hi) const { lo = one(n, lo); hi = one(n + 32, hi); }
  DI bool trans(int) const { return false; }
  DI int valid16(int) const { return 16; }
  DI uint4 post(int, int, int, int, uint4 v) const { return v; }
  DI bf16_t* rowptr(int m0, int n0, int row) const { return C + (size_t)(m0 + row) * ldc + n0; }
  DI void operator()(int, int, float4, float4) const {} };
DI float logsig(float x) { return fminf(x, 0.f) - log1pf(__expf(-fabsf(x))); }
struct EpiMlGate { static constexpr int kBatch = 0; float* GT; const float* bias;
  DI void operator()(int m, int n, float4 v, float4) const {
    if (n >= 16) return;
    const float4 b = *(const float4*)(bias + n); v.x += b.x; v.y += b.y; v.z += b.z; v.w += b.w;
    if ((n >> 2) & 1) { v.x = logsig(v.x); v.y = logsig(v.y); v.z = logsig(v.z); v.w = logsig(v.w); }
    *(float4*)(GT + (size_t)m * 16 + n) = v; } };
struct EpiDaQkv { static constexpr int kBatch = 2; static constexpr bool kF16 = false; bf16_t *Q, *K, *VT;
  DI void xf(int m, int n, float4& lo, float4& hi) const {
    if (n < 2048 && m < T_LAT) {
      const int t = m & 8191; const float prow = (float)(t >> 6), pcol = (float)(t & 63);
      const int d0 = n & 63;
      float x1[4] = {lo.x, lo.y, lo.z, lo.w}, x2[4] = {hi.x, hi.y, hi.z, hi.w};
#pragma unroll
      for (int e = 0; e < 4; ++e) {
        const int d = d0 + e; const int f = d & 15;
        const float inv = __builtin_amdgcn_exp2f(-(float)f * 0.8304820237218406f);
        const float ang = (d < 16 ? prow : pcol) * inv;
        const float cs = __cosf(ang), sn = __sinf(ang);
        const float a = x1[e], b = x2[e];
        x1[e] = a * cs - b * sn; x2[e] = a * sn + b * cs;
      }
      lo = make_float4(x1[0], x1[1], x1[2], x1[3]); hi = make_float4(x2[0], x2[1], x2[2], x2[3]);
    }
  }
  DI bool trans(int n0) const { return n0 >= 2048; }
  DI int valid16(int) const { return 16; }
  DI uint4 post(int, int, int, int, uint4 v) const { return v; }
  DI bf16_t* rowptr(int m0, int n0, int row) const {
    if (n0 < 2048) return (n0 < 1024 ? Q : K) + (size_t)(m0 + row) * DM + (n0 & 1023);
    int b, key;
    if (m0 < T_LAT) { b = m0 >> 13; key = m0 & 8191; } else { b = (m0 - T_LAT) >> 8; key = 8192 + ((m0 - T_LAT) & 255); }
    const int head = (n0 - 2048) >> 7;
    return VT + ((size_t)(b * 8 + head) * 128 + row) * 8448 + key;
  }
  DI void operator()(int, int, float4, float4) const {} };

struct Job { const float* src; bf16_t* dst; int K, N, lds, Kp, Np; };
DI Job mkjob(const float* s, bf16_t* d, int K, int N, int lds, int Kp, int Np) { Job j; j.src = s; j.dst = d; j.K = K; j.N = N; j.lds = lds; j.Kp = Kp; j.Np = Np; return j; }
DI int layer_jobs(const Params& p, int layer, int idx, Job& jb) {
  bf16_t* wb = (bf16_t*)(wsp(p) + OFF_WB);
  const int kind = layer % 3, j = layer / 3;
  if (idx == 0) { jb = mkjob(p.in[I_FWIN] + (size_t)layer * 1024 * 5632, wb + W_FIN, 1024, 5632, 5632, 1024, 5632); }
  else if (idx == 1) { jb = mkjob(p.in[I_FWOUT] + (size_t)layer * 2816 * 1024, wb + W_FOUT, 2816, 1024, 1024, 2816, 1024); }
  else if (kind == 0) {
    const int q = idx - 2;
    if (q < 3) jb = mkjob(p.in[I_RWRKV] + (size_t)(j * 3 + q) * M1, wb + RW_RKV + q * M1, 1024, 1024, 1024, 1024, 1024);
    else if (q == 3) jb = mkjob(p.in[I_RWOUT] + (size_t)j * M1, wb + RW_OUT, 1024, 1024, 1024, 1024, 1024);
    else if (q < 6) jb = mkjob(p.in[I_RW1] + (size_t)(j * 2 + (q - 4)) * 65536, wb + RW_W1C + (q - 4) * 65536, 1024, 64, 64, 1024, 64);
    else if (q < 8) jb = mkjob(p.in[I_RA1] + (size_t)(j * 2 + (q - 6)) * 65536, wb + RW_A1C + (q - 6) * 65536, 1024, 64, 64, 1024, 64);
    else if (q == 8) jb = mkjob(p.in[I_RG1] + (size_t)j * 163840, wb + RW_G1, 1024, 160, 160, 1024, 256);
    else if (q < 11) jb = mkjob(p.in[I_RW2] + (size_t)(j * 2 + (q - 9)) * 65536, wb + RW_W2 + (q - 9) * 65536, 64, 1024, 1024, 64, 1024);
    else if (q < 13) jb = mkjob(p.in[I_RA2] + (size_t)(j * 2 + (q - 11)) * 65536, wb + RW_A2 + (q - 11) * 65536, 64, 1024, 1024, 64, 1024);
    else jb = mkjob(p.in[I_RG2] + (size_t)j * 163840, wb + RW_G2, 160, 1024, 1024, 192, 1024);
    return 16;
  } else if (kind == 1) {
    const int q = idx - 2;
    if (q == 0) jb = mkjob(p.in[I_MWIN] + (size_t)j * 1024 * 3088, wb + ML_WIN, 1024, 3072, 3088, 1024, 3072);
    else if (q == 1) jb = mkjob(p.in[I_MWIN] + (size_t)j * 1024 * 3088 + 3072, wb + ML_WG, 1024, 16, 3088, 1024, 128);
    else jb = mkjob(p.in[I_MWOUT] + (size_t)j * M1, wb + ML_WO, 1024, 1024, 1024, 1024, 1024);
    return 5;
  } else {
    const int q = idx - 2;
    if (q == 0) jb = mkjob(p.in[I_DQKV] + (size_t)j * 3 * M1, wb + DA_QKV, 1024, 3072, 3072, 1024, 3072);
    else jb = mkjob(p.in[I_DWOUT] + (size_t)j * M1, wb + DA_WO, 1024, 1024, 1024, 1024, 1024);
    return 4;
  }
  return kind == 0 ? 16 : (kind == 1 ? 5 : 4);
}
DI void convert_weights(const Params& p, int layer, unsigned char* smem, int qlo = 0, int qhi = 99, int* dyn = nullptr) {
  float* tile = (float*)smem;
  const int tid = tidx();
  int* shw = (int*)(smem + SMEM_BYTES - 32);
  Job jb; const int njobs = layer_jobs(p, layer, 0, jb);
  if (qhi > njobs) qhi = njobs;
  int total = 0;
  for (int q = qlo; q < qhi; ++q) { layer_jobs(p, layer, q, jb); total += (jb.Kp >> 6) * (jb.Np >> 6); }
  int item = blockIdx.x;
  if (dyn) { if (tid == 0) shw[0] = atomicAdd(dyn, 1); __syncthreads(); item = shw[0]; }
  while (item < total) {
    int rem = item, q = qlo;
    for (;; ++q) { layer_jobs(p, layer, q, jb); const int c = (jb.Kp >> 6) * (jb.Np >> 6); if (rem < c) break; rem -= c; }
    const int tnn = jb.Np >> 6; const int kt = rem / tnn, ntl = rem % tnn;
    const int k0 = kt * 64, n0 = ntl * 64;
    const int tx = tid & 63, ty = tid >> 6;
    float tv[16];
#pragma unroll
    for (int i = 0; i < 16; ++i) {
      const int kl = 4 * i + ty, k = k0 + kl, n = n0 + tx;
      tv[i] = (k < jb.K && n < jb.N) ? __builtin_nontemporal_load(jb.src + (size_t)k * jb.lds + n) : 0.f;
    }
#pragma unroll
    for (int i = 0; i < 16; ++i) tile[(4 * i + ty) * 65 + tx] = tv[i];
    __syncthreads();
    {
      const int nl = tid >> 2, kq = tid & 3;
      uint4 o0, o1;
      const float* tp = tile + (16 * kq) * 65 + nl;
      o0.x = pk2(tp[0], tp[65]); o0.y = pk2(tp[2 * 65], tp[3 * 65]); o0.z = pk2(tp[4 * 65], tp[5 * 65]); o0.w = pk2(tp[6 * 65], tp[7 * 65]);
      o1.x = pk2(tp[8 * 65], tp[9 * 65]); o1.y = pk2(tp[10 * 65], tp[11 * 65]); o1.z = pk2(tp[12 * 65], tp[13 * 65]); o1.w = pk2(tp[14 * 65], tp[15 * 65]);
      bf16_t* d = jb.dst + (size_t)(n0 + nl) * jb.Kp + k0 + 16 * kq;
      *(uint4*)d = o0; *(uint4*)(d + 8) = o1;
    }
    __syncthreads();
    if (dyn) { if (tid == 0) shw[0] = atomicAdd(dyn, 1); __syncthreads(); item = shw[0]; } else item += gridDim.x;
  }
}

DI void norm_row_regs(const float* __restrict__ xrow, const float* __restrict__ g, const float* __restrict__ sh, const float* __restrict__ sc, int lane, float (&v)[16]) {
  float ss = 0.f;
#pragma unroll
  for (int j = 0; j < 4; ++j) {
    const float4 x = *(const float4*)(xrow + 4 * lane + 256 * j);
    v[4 * j] = x.x; v[4 * j + 1] = x.y; v[4 * j + 2] = x.z; v[4 * j + 3] = x.w;
    ss += x.x * x.x + x.y * x.y + x.z * x.z + x.w * x.w;
  }
  ss = wave_sum(ss);
  const float rs = __builtin_amdgcn_rsqf(ss * (1.f / 1024.f) + 1e-6f);
#pragma unroll
  for (int j = 0; j < 4; ++j) {
    const int c = 4 * lane + 256 * j;
    const float4 gg = *(const float4*)(g + c);
    float4 s1 = make_float4(0.f, 0.f, 0.f, 0.f), s0 = make_float4(0.f, 0.f, 0.f, 0.f);
    if (sc) { s1 = *(const float4*)(sc + c); s0 = *(const float4*)(sh + c); }
    v[4 * j] = v[4 * j] * rs * gg.x * (1.f + s1.x) + s0.x;
    v[4 * j + 1] = v[4 * j + 1] * rs * gg.y * (1.f + s1.y) + s0.y;
    v[4 * j + 2] = v[4 * j + 2] * rs * gg.z * (1.f + s1.z) + s0.z;
    v[4 * j + 3] = v[4 * j + 3] * rs * gg.w * (1.f + s1.w) + s0.w;
  }
}
DI void store_row_bf16(bf16_t* orow, int lane, const float (&v)[16]) {
#pragma unroll
  for (int j = 0; j < 4; ++j) { uint2 u; u.x = pk2(v[4 * j], v[4 * j + 1]); u.y = pk2(v[4 * j + 2], v[4 * j + 3]); *(uint2*)(orow + 4 * lane + 256 * j) = u; }
}
DI void norm_load(const float* __restrict__ xrow, int lane, float (&v)[16]) {
#pragma unroll
  for (int j = 0; j < 4; ++j) { const float4 x = *(const float4*)(xrow + 4 * lane + 256 * j); v[4 * j] = x.x; v[4 * j + 1] = x.y; v[4 * j + 2] = x.z; v[4 * j + 3] = x.w; }
}
DI void norm_finish(const float* __restrict__ g, const float* __restrict__ sh, const float* __restrict__ sc, int lane, float (&v)[16]) {
  float ss = 0.f;
#pragma unroll
  for (int i = 0; i < 16; ++i) ss += v[i] * v[i];
  ss = wave_sum(ss);
  const float rs = __builtin_amdgcn_rsqf(ss * (1.f / 1024.f) + 1e-6f);
#pragma unroll
  for (int j = 0; j < 4; ++j) {
    const int c = 4 * lane + 256 * j;
    const float4 gg = *(const float4*)(g + c);
    float4 s1 = make_float4(0.f, 0.f, 0.f, 0.f), s0 = make_float4(0.f, 0.f, 0.f, 0.f);
    if (sc) { s1 = *(const float4*)(sc + c); s0 = *(const float4*)(sh + c); }
    v[4 * j] = v[4 * j] * rs * gg.x * (1.f + s1.x) + s0.x;
    v[4 * j + 1] = v[4 * j + 1] * rs * gg.y * (1.f + s1.y) + s0.y;
    v[4 * j + 2] = v[4 * j + 2] * rs * gg.z * (1.f + s1.z) + s0.z;
    v[4 * j + 3] = v[4 * j + 3] * rs * gg.w * (1.f + s1.w) + s0.w;
  }
}
DI void phase_norm(const Params& p, int layer, int which  , bf16_t* out, int nrows = T_ALL) {
  const float* xr = (const float*)(wsp(p) + OFF_XR);
  const float* mod = (const float*)(wsp(p) + OFF_MISC) + (size_t)layer * 3 * 6144;
  const float* g = p.in[which ? I_N2G : I_N1G] + layer * 1024;
  const int lane = tidx() & 63, wid = tidx() >> 6;
  for (int row = (blockIdx.x * 4 + wid) * 2; row < nrows; row += gridDim.x * 8) {
    const float* ms = mod + modset_of(row) * 6144 + (which ? 3 : 0) * 1024;
    float va[16], vb[16];
    norm_load(xr + (size_t)row * DM, lane, va);
    norm_load(xr + (size_t)(row + 1) * DM, lane, vb);
    norm_finish(g, ms, ms + 1024, lane, va);
    norm_finish(g, ms, ms + 1024, lane, vb);
    store_row_bf16(out + (size_t)row * DM, lane, va);
    store_row_bf16(out + (size_t)(row + 1) * DM, lane, vb);
  }
}
DI void phase_norm_shift(const Params& p, int layer, bf16_t* hb, bf16_t* xxb, const float* mix, bf16_t* xs0, bf16_t* xs1, bf16_t* xs2) {
  const float* xr = (const float*)(wsp(p) + OFF_XR);
  const float* mod = (const float*)(wsp(p) + OFF_MISC) + (size_t)layer * 3 * 6144;
  const float* g = p.in[I_N1G] + layer * 1024;
  const int lane = tidx() & 63, wid = tidx() >> 6;
  float mr[16], mk[16], mv[16];
#pragma unroll
  for (int jq = 0; jq < 4; ++jq) {
    const float4 a = *(const float4*)(mix + 4 * lane + 256 * jq), b = *(const float4*)(mix + 1024 + 4 * lane + 256 * jq), c = *(const float4*)(mix + 2048 + 4 * lane + 256 * jq);
    mr[4 * jq] = a.x; mr[4 * jq + 1] = a.y; mr[4 * jq + 2] = a.z; mr[4 * jq + 3] = a.w;
    mk[4 * jq] = b.x; mk[4 * jq + 1] = b.y; mk[4 * jq + 2] = b.z; mk[4 * jq + 3] = b.w;
    mv[4 * jq] = c.x; mv[4 * jq + 1] = c.y; mv[4 * jq + 2] = c.z; mv[4 * jq + 3] = c.w;
  }
  for (int u = blockIdx.x * 4 + wid; u < T_ALL / 16; u += gridDim.x * 4) {
    const int row0 = u * 16;
    int s0, len;
    if (row0 < T_LAT) { s0 = row0 & ~8191; len = 8192; } else { s0 = T_LAT + ((row0 - T_LAT) & ~255); len = 256; }
    const float* ms = mod + modset_of(row0) * 6144;
    float prev[16], cur[16], nxt[16], raw[16];
    if (row0 > s0) norm_row_regs(xr + (size_t)(row0 - 1) * DM, g, ms, ms + 1024, lane, prev);
    else {
#pragma unroll
      for (int i = 0; i < 16; ++i) prev[i] = 0.f;
    }
    norm_row_regs(xr + (size_t)row0 * DM, g, ms, ms + 1024, lane, cur);
    if (row0 + 1 < s0 + len) norm_load(xr + (size_t)(row0 + 1) * DM, lane, raw);
    for (int i = 0; i < 16; ++i) {
      const int row = row0 + i;
      const bool has1 = row + 1 < s0 + len, has2 = row + 2 < s0 + len && i < 15;
#pragma unroll
      for (int e = 0; e < 16; ++e) nxt[e] = raw[e];
      if (has2) norm_load(xr + (size_t)(row + 2) * DM, lane, raw);
      if (has1) norm_finish(g, ms, ms + 1024, lane, nxt);
      else {
#pragma unroll
        for (int e = 0; e < 16; ++e) nxt[e] = 0.f;
      }
      float xx[16];
#pragma unroll
      for (int e = 0; e < 16; ++e) xx[e] = 0.5f * (prev[e] + nxt[e]) - cur[e];
      store_row_bf16(hb + (size_t)row * DM, lane, cur);
      store_row_bf16(xxb + (size_t)row * DM, lane, xx);
      {
        float t[16];
#pragma unroll
        for (int e = 0; e < 16; ++e) t[e] = cur[e] + xx[e] * mr[e];
        store_row_bf16(xs0 + (size_t)row * DM, lane, t);
#pragma unroll
        for (int e = 0; e < 16; ++e) t[e] = cur[e] + xx[e] * mk[e];
        store_row_bf16(xs1 + (size_t)row * DM, lane, t);
#pragma unroll
        for (int e = 0; e < 16; ++e) t[e] = cur[e] + xx[e] * mv[e];
        store_row_bf16(xs2 + (size_t)row * DM, lane, t);
      }
#pragma unroll
      for (int e = 0; e < 16; ++e) { prev[e] = cur[e]; cur[e] = nxt[e]; }
    }
  }
}

DI void phase0(const Params& p, unsigned char* smem) {
  const int tid = tidx();
  {
    float4* xr = (float4*)(wsp(p) + OFF_XR);
    const float4* x = (const float4*)p.in[I_X]; const float4* cx = (const float4*)p.in[I_CTX];
    const size_t nl = (size_t)T_LAT * DM / 4, na = (size_t)T_ALL * DM / 4;
    for (size_t i = (size_t)blockIdx.x * 256 + tid; i < na; i += (size_t)gridDim.x * 256) xr[i] = i < nl ? x[i] : cx[i - nl];
  }
  if (blockIdx.x == 0) { int* cnt = (int*)(wsp(p) + OFF_MISC + MISC_CNT); for (int i = tid; i < 8192 + 8; i += 256) cnt[i] = 0; }
  float* sv = (float*)smem;
  float* red = sv + 3 * 1024;
  for (int i = tid; i < 3 * 1024; i += 256) {
    const float c = i < 2048 ? p.in[I_C][i] : p.in[I_CCTX][i - 2048];
    sv[i] = c / (1.f + __expf(-c));
  }
  __syncthreads();
  float* mod = (float*)(wsp(p) + OFF_MISC);
  for (int item = blockIdx.x; item < 4 * 96; item += gridDim.x) {
    const int l = item / 96, j0 = (item % 96) * 64, kg = tid >> 6, jj = tid & 63;
    const float* w = p.in[I_ADAW] + (size_t)l * 1024 * 6144 + (size_t)(kg * 256) * 6144 + j0 + jj;
    float a0 = 0.f, a1 = 0.f, a2 = 0.f;
#pragma unroll 32
    for (int k = 0; k < 256; ++k) {
      const float wv = __builtin_nontemporal_load(w + (size_t)k * 6144);
      a0 += sv[kg * 256 + k] * wv; a1 += sv[1024 + kg * 256 + k] * wv; a2 += sv[2048 + kg * 256 + k] * wv;
    }
    red[(kg * 3 + 0) * 64 + jj] = a0; red[(kg * 3 + 1) * 64 + jj] = a1; red[(kg * 3 + 2) * 64 + jj] = a2;
    __syncthreads();
    if (tid < 192) {
      const int s = tid >> 6;
      const float r = red[(0 * 3 + s) * 64 + jj] + red[(1 * 3 + s) * 64 + jj] + red[(2 * 3 + s) * 64 + jj] + red[(3 * 3 + s) * 64 + jj];
      mod[((size_t)l * 3 + s) * 6144 + j0 + jj] = r + p.in[I_ADAB][l * 6144 + j0 + jj];
    }
    __syncthreads();
  }
}

DI void phase_ffn_in(const Params& p, unsigned char* smem, const bf16_t* hb, bf16_t* vg, int rowtiles) {
  const bf16_t* wb = (const bf16_t*)(wsp(p) + OFF_WB);
  EpiBf16 epi{vg, 5632, 5632, 0};
  const int rt2 = rowtiles >> 1;
  const int ntile = rt2 * 44;
  XCD_FOR(t, ntile) {
    const int per_g = 4 * 44, g = t / per_g, idx = t - g * per_g, rows = (rt2 - 4 * g) < 4 ? (rt2 - 4 * g) : 4;
    gemm_tile_big(smem, hb, DM, wb + W_FIN, DM, 1024, 4 * g + idx % rows, idx / rows, epi);
  }
}
DI float gelu_tanh(float x) { const float u = 0.7978845608028654f * (x + 0.044715f * x * x * x); return x * __builtin_amdgcn_rcpf(1.f + __expf(-2.f * u)); }
DI void phase_ffn_act(const Params& p, int layer, bf16_t* vg, int nrows) {
  const float* cw = p.in[I_FCW] + (size_t)layer * 3 * FF; const float* cb = p.in[I_FCB] + (size_t)layer * FF;
  const size_t total = (size_t)nrows * (FF / 8);
  for (size_t i = (size_t)blockIdx.x * 256 + tidx(); i < total; i += (size_t)gridDim.x * 256) {
    const int row = (int)(i / (FF / 8)), f0 = (int)(i % (FF / 8)) * 8;
    int s0, len;
    if (row < T_LAT) { s0 = row & ~8191; len = 8192; } else { s0 = T_LAT + ((row - T_LAT) & ~255); len = 256; }
    const bf16_t* vr = vg + (size_t)row * 5632;
    const uint4 val = *(const uint4*)(vr + f0);
    const uint4 gc = *(const uint4*)(vr + FF + f0);
    uint4 gp = make_uint4(0, 0, 0, 0), gn = make_uint4(0, 0, 0, 0);
    if (row > s0) gp = *(const uint4*)(vr - 5632 + FF + f0);
    if (row + 1 < s0 + len) gn = *(const uint4*)(vr + 5632 + FF + f0);
    const unsigned va[4] = {val.x, val.y, val.z, val.w}, ca[4] = {gc.x, gc.y, gc.z, gc.w}, pa[4] = {gp.x, gp.y, gp.z, gp.w}, na[4] = {gn.x, gn.y, gn.z, gn.w};
    const float4 w0a = *(const float4*)(cw + f0), w0b = *(const float4*)(cw + f0 + 4), w1a = *(const float4*)(cw + FF + f0), w1b = *(const float4*)(cw + FF + f0 + 4);
    const float4 w2a = *(const float4*)(cw + 2 * FF + f0), w2b = *(const float4*)(cw + 2 * FF + f0 + 4), cba = *(const float4*)(cb + f0), cbb = *(const float4*)(cb + f0 + 4);
    const float t0[8] = {w0a.x, w0a.y, w0a.z, w0a.w, w0b.x, w0b.y, w0b.z, w0b.w}, t1[8] = {w1a.x, w1a.y, w1a.z, w1a.w, w1b.x, w1b.y, w1b.z, w1b.w};
    const float t2[8] = {w2a.x, w2a.y, w2a.z, w2a.w, w2b.x, w2b.y, w2b.z, w2b.w}, tb[8] = {cba.x, cba.y, cba.z, cba.w, cbb.x, cbb.y, cbb.z, cbb.w};
    unsigned o[4];
#pragma unroll
    for (int e = 0; e < 4; ++e) {
      const float g0 = t0[2 * e] * bflo(pa[e]) + t1[2 * e] * bflo(ca[e]) + t2[2 * e] * bflo(na[e]) + tb[2 * e];
      const float g1 = t0[2 * e + 1] * bfhi(pa[e]) + t1[2 * e + 1] * bfhi(ca[e]) + t2[2 * e + 1] * bfhi(na[e]) + tb[2 * e + 1];
      o[e] = pk2(gelu_tanh(g0) * bflo(va[e]), gelu_tanh(g1) * bfhi(va[e]));
    }
    *(uint4*)(vg + (size_t)row * 5632 + f0) = make_uint4(o[0], o[1], o[2], o[3]);
  }
}
DI void phase_gemm_resid(const Params& p, unsigned char* smem, int layer, const bf16_t* A, int lda, int K, const bf16_t* Wt, int gate_chunk, int rowtiles = 132) {
  EpiResid epi{(float*)(wsp(p) + OFF_XR), (const float*)(wsp(p) + OFF_MISC) + (size_t)layer * 3 * 6144 + gate_chunk * 1024};
  XCD_FOR(t, 512) { const int g = t >> 6, idx = t & 63; gemm_tile_big(smem, A, lda, Wt, K, K, 8 * g + (idx & 7), idx >> 3, epi); }
  if (rowtiles > 128) XCD_FOR(t, 32) gemm_tile<false>(smem, A, nullptr, nullptr, lda, Wt, K, K, 128 + (t & 3), t >> 2, epi);
}

constexpr size_t RA_R = 0, RA_K = 33, RA_V = 66, RA_E0 = 99, RA_E1 = 132, RA_A0 = 165, RA_A1 = 198, RA_HB = 99, RA_XX = 132,
                 RA_Y1 = 231, RA_Z0 = 99, RA_ZB = 132;
constexpr size_t RO_Y0 = 0, RO_LW = 33, RO_LA = 38, RO_LG = 43, RO_CB = 50;
DI unsigned char* outp(const Params& p, size_t mib) { size_t z = 0; asm volatile("" : "+s"(z)); return (unsigned char*)p.out + mib * MiB + z; }
DI unsigned char* actp(const Params& p, size_t mib) { return wsp(p) + OFF_ACT + mib * MiB; }

constexpr size_t RA_XS0 = 165, RA_XS1 = 198, RA_XS2 = 231;
DI void phase_rwkv_proj1(const Params& p, int j, unsigned char* smem) {
  const bf16_t* wb = (const bf16_t*)(wsp(p) + OFF_WB);
  const bf16_t* hb = (const bf16_t*)actp(p, RA_HB); const bf16_t* xx = (const bf16_t*)actp(p, RA_XX);
  const float* mix = p.in[I_RMIX] + (size_t)j * 6 * 1024;
  XCD_FOR(t, 3 * 512) {
    const int q = t >> 9, r = t & 511, g = r >> 6, idx = r & 63;
    EpiF16 epi{(f16_t*)actp(p, RA_R + 33 * q)};
    gemm_tile_big(smem, (const bf16_t*)actp(p, RA_XS0 + 33 * q), DM, wb + RW_RKV + q * M1, DM, 1024, 8 * g + (idx & 7), idx >> 3, epi);
  }
  const int total = 96 + 132 + 132 + 264;
  XCD_FOR(t, total) {
    if (t < 96) {
      const int q = t >> 5, r = t & 31;
      EpiF16 epi{(f16_t*)actp(p, RA_R + 33 * q)};
      gemm_tile<false>(smem, (const bf16_t*)actp(p, RA_XS0 + 33 * q), nullptr, nullptr, DM, wb + RW_RKV + q * M1, DM, 1024, 128 + (r & 3), r >> 2, epi);
    } else if (t < 96 + 132) {
      const int r = t - 96;
      EpiBf16 epi{(bf16_t*)outp(p, RO_LW), 128, 128, 1};
      gemm_tile<true>(smem, hb, xx, mix + 3 * 1024, DM, wb + RW_W1C, DM, 1024, r, 0, epi);
    } else if (t < 96 + 264) {
      const int r = t - 96 - 132;
      EpiBf16 epi{(bf16_t*)outp(p, RO_LA), 128, 128, 0};
      gemm_tile<true>(smem, hb, xx, mix + 4 * 1024, DM, wb + RW_A1C, DM, 1024, r, 0, epi);
    } else {
      const int r = t - 96 - 264;
      EpiBf16 epi{(bf16_t*)outp(p, RO_LG), 192, 192, 2};
      gemm_tile<true>(smem, hb, xx, mix + 5 * 1024, DM, wb + RW_G1, DM, 1024, swz_tm(r, 2), swz_tn(r, 2), epi);
    }
  }
}
DI void phase_rwkv_proj2(const Params& p, int j, unsigned char* smem) {
  const bf16_t* wb = (const bf16_t*)(wsp(p) + OFF_WB);
  auto mkA = [&](int q) -> const bf16_t* { const int d = q & 1; return (const bf16_t*)outp(p, q < 2 ? RO_LW : RO_LA) + d * 64; };
  auto mkB = [&](int q) -> const bf16_t* { const int d = q & 1; return wb + (q < 2 ? RW_W2 : RW_A2) + d * 65536; };
  auto mkE = [&](int q) { const int d = q & 1;
    EpiDecay epi; epi.C = (f16_t*)actp(p, q < 2 ? (d ? RA_E1 : RA_E0) : (d ? RA_A1 : RA_A0)); epi.bias = p.in[q < 2 ? I_RW0 : I_RA0] + (size_t)(j * 2 + d) * 1024; epi.mode = q < 2 ? 0 : 1; return epi; };
  XCD_FOR(t, 4 * 512) { const int q = t >> 9, r = t & 511, g = r >> 6, idx = r & 63; const EpiDecay epi = mkE(q);
    gemm_tile_big(smem, mkA(q), 128, mkB(q), 64, 64, 8 * g + (idx & 7), idx >> 3, epi); }
  XCD_FOR(t, 4 * 32) { const int q = t >> 5, r = t & 31; const EpiDecay epi = mkE(q);
    gemm_tile<false>(smem, mkA(q), nullptr, nullptr, 128, mkB(q), 64, 64, 128 + (r & 3), r >> 2, epi); }
}

constexpr int SC_BUF = 25600;
typedef float f32x2 __attribute__((ext_vector_type(2)));
DI unsigned hw_cu_key() {
  const unsigned xcc = (unsigned)__builtin_amdgcn_s_getreg((3 << 11) | 20) & 0xFu;
  const unsigned cu = ((unsigned)__builtin_amdgcn_s_getreg(63492) >> 8) & 0xFFu;
  return xcc * 256u + cu;
}
DI void phase_rwkv_scan(const Params& p, int j, unsigned char* smem, int cset) {
  const f16_t* RB = (const f16_t*)actp(p, RA_R); const f16_t* KB = (const f16_t*)actp(p, RA_K); const f16_t* VB = (const f16_t*)actp(p, RA_V);
  float* CB = (float*)outp(p, RO_CB);
  int* cuCnt = (int*)(wsp(p) + OFF_MISC + MISC_CNT) + cset * 2048; int* itemCnt = (int*)(wsp(p) + OFF_MISC + MISC_CNT) + 8192 + cset;
  const int tid = tidx(), lane = tid & 63, wv = tid >> 6;
  const int stj = tid >> 4, scg = tid & 15;
  const int g = lane & 15, rl = wv * 4 + (lane >> 4);
  int* shi = (int*)(smem + SMEM_BYTES - 16);
  if (tid == 0) {
    const int k = atomicAdd(cuCnt + hw_cu_key(), 1);
    shi[0] = (k == 0) ? atomicAdd(itemCnt, 1) : 256;
  }
  __syncthreads();
  int item = shi[0];
  while (item < 256) {
    const int hd = item >> 2, rg = item & 3, dir = hd & 1, bh = hd >> 1, b = bh >> 4, h = bh & 15;
    const f16_t* EB = (const f16_t*)actp(p, dir ? RA_E1 : RA_E0); const f16_t* AB = (const f16_t*)actp(p, dir ? RA_A1 : RA_A0);
    bf16_t* YB = dir ? (bf16_t*)actp(p, RA_Y1) : (bf16_t*)outp(p, RO_Y0);
    const int ch = h * 64 + 4 * scg;
    const float4 kk4 = *(const float4*)(p.in[I_RKK] + j * 1024 + ch), ka4 = *(const float4*)(p.in[I_RKA] + j * 1024 + ch),
                 rk4 = *(const float4*)(p.in[I_RRK] + j * 1024 + ch);
    f32x2 Sa = {0.f, 0.f}, Sb = {0.f, 0.f};
    f16x4 pr, pk, pe, pa; f16_t pv;
    auto rowof = [&](int cidx, int jj) -> int {
      int base;
      if (cidx < 16) base = T_LAT + b * 256 + 16 * (dir ? 15 - cidx : cidx);
      else { const int lc = cidx - 16; base = b * 8192 + 16 * (dir ? 511 - lc : lc); }
      return base + (dir ? 15 - jj : jj);
    };
    auto gload = [&](int cidx) {
      const size_t row = (size_t)rowof(cidx, stj);
      pr = *(const f16x4*)(RB + row * DM + ch); pk = *(const f16x4*)(KB + row * DM + ch);
      pe = *(const f16x4*)(EB + row * DM + ch); pa = *(const f16x4*)(AB + row * DM + ch);
      pv = VB[row * DM + h * 64 + 16 * rg + scg];
    };
    auto lwrite = [&](int cidx) {
      float* dat = (float*)(smem + (cidx & 1) * SC_BUF);
      const float kf[4] = {(float)pk[0], (float)pk[1], (float)pk[2], (float)pk[3]};
      const float af[4] = {(float)pa[0], (float)pa[1], (float)pa[2], (float)pa[3]};
      const float rf[4] = {(float)pr[0], (float)pr[1], (float)pr[2], (float)pr[3]};
      const float kkc[4] = {kk4.x, kk4.y, kk4.z, kk4.w}, kac[4] = {ka4.x, ka4.y, ka4.z, ka4.w}, rkc[4] = {rk4.x, rk4.y, rk4.z, rk4.w};
      float kkr[4], ss = 0.f;
#pragma unroll
      for (int e = 0; e < 4; ++e) { kkr[e] = kf[e] * kkc[e]; ss += kkr[e] * kkr[e]; }
      ss = allreduce16(ss);
      const float inv = __builtin_amdgcn_rsqf(fmaxf(ss, 1e-24f));
      float kk[4], w[4], kka[4], kd[4], cbp = 0.f;
#pragma unroll
      for (int e = 0; e < 4; ++e) {
        kk[e] = kkr[e] * inv; w[e] = __expf(-(float)pe[e]); kka[e] = kk[e] * af[e];
        kd[e] = kf[e] * (1.f + (af[e] - 1.f) * kac[e]); cbp += rf[e] * kd[e] * rkc[e];
      }
      cbp = allreduce16(cbp);
      float* d0 = dat + stj * 320 + 4 * scg;
      *(float4*)(d0) = make_float4(kk[0], kk[1], kk[2], kk[3]);
      *(float4*)(d0 + 64) = make_float4(w[0], w[1], w[2], w[3]);
      *(float4*)(d0 + 128) = make_float4(kka[0], kka[1], kka[2], kka[3]);
      *(float4*)(d0 + 192) = make_float4(kd[0], kd[1], kd[2], kd[3]);
      *(float4*)(d0 + 256) = make_float4(rf[0], rf[1], rf[2], rf[3]);
      dat[5120 + stj * 16 + scg] = (float)pv;
      if (rg == 0 && scg == 0) CB[((size_t)dir * T_ALL + rowof(cidx, stj)) * 16 + h] = cbp;
    };
    auto yflush = [&](int cidx) {
      const float4 y4 = *(const float4*)((const float*)(smem + (cidx & 1) * SC_BUF) + 5376 + (stj * 16 + scg) * 4);
      YB[(size_t)rowof(cidx, stj) * DM + h * 64 + 16 * rg + scg] = (bf16_t)f2bf((y4.x + y4.y) + (y4.z + y4.w));
    };
    gload(0);
    const int NCH = 528;
    for (int c = 0; c < NCH; ++c) {
      lwrite(c);
      __syncthreads();
      if (c > 0) yflush(c - 1);
      if (c + 1 < NCH) gload(c + 1);
      const float* dat = (const float*)(smem + (c & 1) * SC_BUF);
      float* yp = ((g & 3) == 0) ? ((float*)(smem + (c & 1) * SC_BUF) + 5376 + rl * 4 + (g >> 2)) : ((float*)(smem + 2 * SC_BUF) + (lane & 63));
      const float* dl = dat + 4 * g;
      const float* vl = dat + 5120 + rl;
#define SC_LOAD(jj_, K_, W_, A_, D_, R_, V_) do { const float* d_ = dl + (jj_) * 320; K_ = *(const f32x4*)(d_); W_ = *(const f32x4*)(d_ + 64); \
        A_ = *(const f32x4*)(d_ + 128); D_ = *(const f32x4*)(d_ + 192); R_ = *(const f32x4*)(d_ + 256); V_ = vl[(jj_) * 16]; } while (0)
#define SC_STEP(jj_, K_, W_, A_, D_, R_, V_) do { \
        f32x2 pa2 = Sa * K_.xy; pa2 = Sb * K_.zw + pa2; \
        const float sa = allreduce16(pa2.x + pa2.y); \
        const f32x2 nsa = {-sa, -sa}, v2 = {V_, V_}; \
        f32x2 ta = v2 * D_.xy; ta = nsa * A_.xy + ta; Sa = Sa * W_.xy + ta; \
        f32x2 tb = v2 * D_.zw; tb = nsa * A_.zw + tb; Sb = Sb * W_.zw + tb; \
        f32x2 ya = Sa * R_.xy; ya = Sb * R_.zw + ya; \
        float y = ya.x + ya.y; y += dpp_f<0xB1>(y); y += dpp_f<0x4E>(y); \
        yp[(jj_) * 64] = y; } while (0)
      f32x4 k0, w0, a0, d0, r0, k1, w1, a1, d1, r1; float v0, v1;
      SC_LOAD(0, k0, w0, a0, d0, r0, v0);
#pragma unroll
      for (int jj = 0; jj < 16; jj += 2) {
        SC_LOAD(jj + 1, k1, w1, a1, d1, r1, v1);
        SC_STEP(jj, k0, w0, a0, d0, r0, v0);
        if (jj + 2 < 16) SC_LOAD(jj + 2, k0, w0, a0, d0, r0, v0);
        SC_STEP(jj + 1, k1, w1, a1, d1, r1, v1);
      }
    }
    __syncthreads();
    yflush(NCH - 1);
    __syncthreads();
    if (tid == 0) shi[0] = atomicAdd(itemCnt, 1);
    __syncthreads();
    item = shi[0];
  }
  __syncthreads();
  convert_weights(p, 3 * j, smem, 0, 2, (int*)(wsp(p) + OFF_MISC + MISC_CNT) + 8192 + 4 + cset);
}
DI void phase_rwkv_post(const Params& p, int j, int nrows) {
  const bf16_t* Y0 = (const bf16_t*)outp(p, RO_Y0); const bf16_t* Y1 = (const bf16_t*)actp(p, RA_Y1);
  const f16_t* VB = (const f16_t*)actp(p, RA_V); const float* CB = (const float*)outp(p, RO_CB);
  bf16_t* Z0 = (bf16_t*)actp(p, RA_Z0);
  const float* lg = p.in[I_RLNG] + j * 1024; const float* lb = p.in[I_RLNB] + j * 1024;
  const int lane = tidx() & 63, wid = tidx() >> 6;
  for (int row = blockIdx.x * 4 + wid; row < nrows; row += gridDim.x * 4) {
    const int c0 = 16 * lane, h = lane >> 2;
    const uint4 a0 = *(const uint4*)(Y0 + (size_t)row * DM + c0), a1 = *(const uint4*)(Y0 + (size_t)row * DM + c0 + 8);
    const uint4 b0 = *(const uint4*)(Y1 + (size_t)row * DM + c0), b1 = *(const uint4*)(Y1 + (size_t)row * DM + c0 + 8);
    const unsigned ya[8] = {a0.x, a0.y, a0.z, a0.w, a1.x, a1.y, a1.z, a1.w}, yb[8] = {b0.x, b0.y, b0.z, b0.w, b1.x, b1.y, b1.z, b1.w};
    float y[16], s = 0.f;
#pragma unroll
    for (int e = 0; e < 8; ++e) { y[2 * e] = bflo(ya[e]) + bflo(yb[e]); y[2 * e + 1] = bfhi(ya[e]) + bfhi(yb[e]); s += y[2 * e] + y[2 * e + 1]; }
    s += dpp_f<0xB1>(s); s += dpp_f<0x4E>(s);
    const float mu = s * (1.f / 64.f);
    float q = 0.f;
#pragma unroll
    for (int e = 0; e < 16; ++e) { const float d = y[e] - mu; q += d * d; }
    q += dpp_f<0xB1>(q); q += dpp_f<0x4E>(q);
    const float rs = __builtin_amdgcn_rsqf(q * (1.f / 64.f) + 6.4e-4f);
    const float cb = CB[(size_t)row * 16 + h] + CB[((size_t)T_ALL + row) * 16 + h];
    const f16_t* vp = VB + (size_t)row * DM + c0;
    unsigned o[8];
#pragma unroll
    for (int e = 0; e < 8; ++e) {
      const int c = c0 + 2 * e;
      const float z0 = (y[2 * e] - mu) * rs * lg[c] + lb[c] + cb * (float)vp[2 * e];
      const float z1 = (y[2 * e + 1] - mu) * rs * lg[c + 1] + lb[c + 1] + cb * (float)vp[2 * e + 1];
      o[e] = pk2(z0, z1);
    }
    *(uint4*)(Z0 + (size_t)row * DM + c0) = make_uint4(o[0], o[1], o[2], o[3]);
    *(uint4*)(Z0 + (size_t)row * DM + c0 + 8) = make_uint4(o[4], o[5], o[6], o[7]);
  }
}
DI void phase_rwkv_gate(const Params& p, unsigned char* smem, int rowtiles) {
  const bf16_t* wb = (const bf16_t*)(wsp(p) + OFF_WB);
  EpiMulZ epi{(bf16_t*)actp(p, RA_ZB), (const bf16_t*)actp(p, RA_Z0)};
  XCD_FOR(t, 512) { const int g = t >> 6, idx = t & 63; gemm_tile_big(smem, (const bf16_t*)outp(p, RO_LG), 192, wb + RW_G2, 192, 192, 8 * g + (idx & 7), idx >> 3, epi); }
  if (rowtiles > 128) XCD_FOR(t, 32) gemm_tile<false>(smem, (const bf16_t*)outp(p, RO_LG), nullptr, nullptr, 192, wb + RW_G2, 192, 192, 128 + (t & 3), t >> 2, epi);
}

constexpr size_t MA_HB = 0, MA_Q = 33, MA_K = 50, MA_V = 67, MA_O = 100, MA_GT = 133, MA_CT = 135, MA_NL = 201, MA_DEC = 202, MA_H1 = 203, MA_ZB = 0;
DI void phase_ml_in(const Params& p, int j, unsigned char* smem) {
  const bf16_t* wb = (const bf16_t*)(wsp(p) + OFF_WB);
  const bf16_t* hb = (const bf16_t*)actp(p, MA_HB);
  const float* bias = p.in[I_MBIN] + (size_t)j * 3088;
  auto mk = [&](int tn) {
    const int n0 = tn * 128;
    EpiMlIn epi;
    epi.bias = bias; epi.scale = 1.f; epi.act = 0;
    if (n0 < 512) { epi.C = (bf16_t*)actp(p, MA_Q); epi.ldc = 512; }
    else if (n0 < 1024) { epi.C = (bf16_t*)actp(p, MA_K) - 512; epi.ldc = 512; epi.scale = 0.08838834764831845f; }
    else if (n0 < 2048) { epi.C = (bf16_t*)actp(p, MA_V) - 1024; epi.ldc = 1024; }
    else { epi.C = (bf16_t*)actp(p, MA_O) - 2048; epi.ldc = 1024; epi.act = 1; }
    return epi;
  };
  XCD_FOR(t, 64 * 24) { const int g = t / 192, idx = t % 192, tn = idx >> 3; const EpiMlIn epi = mk(tn); gemm_tile_big(smem, hb, DM, wb + ML_WIN, DM, 1024, 8 * g + (idx & 7), tn, epi); }
  XCD_FOR(t, 96) { const int tn = t >> 2; const EpiMlIn epi = mk(tn); gemm_tile<false>(smem, hb, nullptr, nullptr, DM, wb + ML_WIN, DM, 1024, 128 + (t & 3), tn, epi); }
  XCD_FOR(t, 132) { EpiMlGate epi{(float*)actp(p, MA_GT), bias + 3072}; gemm_tile<false>(smem, hb, nullptr, nullptr, DM, wb + ML_WG, DM, 1024, t, 0, epi); }
}
DI int ml_row(int b, int dir, int c, int s) {
  if (c < 2) { const int pp = c * 128 + s; return T_LAT + b * 256 + (dir ? 255 - pp : pp); }
  const int pp = (c - 2) * 128 + s; return b * 8192 + (dir ? 8191 - pp : pp);
}
DI void ml_gates(const float* GT, int b, int head, int dir, int c, float* bc, float* li, float* tmp) {
  const int tid = tidx();
  if (tid < 128) {
    const int row = ml_row(b, dir, c, tid);
    li[tid] = GT[(size_t)row * 16 + dir * 8 + head];
    tmp[tid] = GT[(size_t)row * 16 + dir * 8 + 4 + head];
  }
  __syncthreads();
  if (tid < 128) {
    const int ln = tid & 63;
    float v = tmp[tid];
#pragma unroll
    for (int d = 1; d < 64; d <<= 1) { const float t = __shfl_up(v, d); if (ln >= d) v += t; }
    if (tid == 63) tmp[128 + 0] = v;
    bc[tid] = v;
  }
  __syncthreads();
  if (tid >= 64 && tid < 128) bc[tid] += tmp[128];
  __syncthreads();
}
DI void phase_ml_cloc(const Params& p, unsigned char* smem) {
  const bf16_t* KB = (const bf16_t*)actp(p, MA_K); const bf16_t* VB = (const bf16_t*)actp(p, MA_V); const float* GT = (const float*)actp(p, MA_GT);
  bf16_t* CT = (bf16_t*)actp(p, MA_CT); float* NL = (float*)actp(p, MA_NL); float* DEC = (float*)actp(p, MA_DEC);
  const int tid = tidx(), lane = tid & 63, wv = tid >> 6, r32 = lane & 31, hh = lane >> 5;
  unsigned char* sVT = smem;
  unsigned char* sKT = smem + 36864;
  float* bc = (float*)(smem + 55296); float* li = bc + 128; float* tmp = li + 128; float* wts = tmp + 128;
  for (int item = blockIdx.x; item < 16 * 66; item += gridDim.x) {
    const int seq = item / 66, c = item % 66, dir = seq & 1, bh = seq >> 1, b = bh >> 2, head = bh & 3;
    ml_gates(GT, b, head, dir, c, bc, li, tmp);
    if (tid < 128) wts[tid] = __expf(bc[127] - bc[tid] + li[tid]);
    __syncthreads();
    f32x16 acc[4][2];
#pragma unroll
    for (int a = 0; a < 4; ++a)
#pragma unroll
      for (int bb = 0; bb < 2; ++bb)
#pragma unroll
        for (int i = 0; i < 16; ++i) acc[a][bb][i] = 0.f;
    float nacc = 0.f;
    for (int half = 0; half < 2; ++half) {
      {
        uint4 dv[8];
#pragma unroll
        for (int q = 0; q < 8; ++q) {
          const int cidx = tid + 256 * q, s_ = cidx & 63, vc = cidx >> 6;
          dv[q] = *(const uint4*)(VB + (size_t)ml_row(b, dir, c, half * 64 + s_) * DM + head * 256 + vc * 8);
        }
        uint4 dk[4];
#pragma unroll
        for (int q = 0; q < 4; ++q) {
          const int cidx = tid + 256 * q, s_ = cidx & 63, kc = cidx >> 6;
          dk[q] = *(const uint4*)(KB + (size_t)ml_row(b, dir, c, half * 64 + s_) * 512 + head * 128 + kc * 8);
        }
#pragma unroll
        for (int q = 0; q < 8; ++q) {
          const int cidx = tid + 256 * q, s_ = cidx & 63, vc = cidx >> 6;
          const unsigned dd[4] = {dv[q].x, dv[q].y, dv[q].z, dv[q].w};
#pragma unroll
          for (int e = 0; e < 4; ++e) {
            *(bf16_t*)(sVT + (vc * 8 + 2 * e) * 144 + s_ * 2) = (bf16_t)(dd[e] & 0xffff);
            *(bf16_t*)(sVT + (vc * 8 + 2 * e + 1) * 144 + s_ * 2) = (bf16_t)(dd[e] >> 16);
          }
        }
#pragma unroll
        for (int q = 0; q < 4; ++q) {
          const int cidx = tid + 256 * q, s_ = cidx & 63, kc = cidx >> 6;
          const float w = wts[half * 64 + s_];
          const unsigned dd[4] = {dk[q].x, dk[q].y, dk[q].z, dk[q].w};
#pragma unroll
          for (int e = 0; e < 4; ++e) {
            *(bf16_t*)(sKT + (kc * 8 + 2 * e) * 144 + s_ * 2) = (bf16_t)f2bf(bflo(dd[e]) * w);
            *(bf16_t*)(sKT + (kc * 8 + 2 * e + 1) * 144 + s_ * 2) = (bf16_t)f2bf(bfhi(dd[e]) * w);
          }
        }
      }
      __syncthreads();
      if (tid < 128) { const bf16_t* kr = (const bf16_t*)(sKT + tid * 144); for (int s = 0; s < 64; ++s) nacc += bf2f(kr[s]); }
#pragma unroll
      for (int ks = 0; ks < 4; ++ks) {
        bf16x8 kf[4], vf[2];
#pragma unroll
        for (int a = 0; a < 4; ++a) kf[a] = *(const bf16x8*)(sKT + (32 * a + r32) * 144 + ks * 32 + hh * 16);
#pragma unroll
        for (int bb = 0; bb < 2; ++bb) vf[bb] = *(const bf16x8*)(sVT + (64 * wv + 32 * bb + r32) * 144 + ks * 32 + hh * 16);
#pragma unroll
        for (int a = 0; a < 4; ++a)
#pragma unroll
          for (int bb = 0; bb < 2; ++bb) acc[a][bb] = mfma32(kf[a], vf[bb], acc[a][bb]);
      }
      __syncthreads();
    }
    bf16_t* ct = CT + (size_t)item * 32768;
#pragma unroll
    for (int a = 0; a < 4; ++a)
#pragma unroll
      for (int bb = 0; bb < 2; ++bb)
#pragma unroll
        for (int ig = 0; ig < 4; ++ig) {
          const int v = 64 * wv + 32 * bb + r32, k = 32 * a + 8 * ig + 4 * hh;
          st_bf16x4(ct + v * 128 + k, make_float4(acc[a][bb][4 * ig], acc[a][bb][4 * ig + 1], acc[a][bb][4 * ig + 2], acc[a][bb][4 * ig + 3]));
        }
    if (tid < 128) NL[(size_t)item * 128 + tid] = nacc;
    if (tid == 0) DEC[item] = __expf(bc[127]);
    __syncthreads();
  }
}
DI void phase_ml_cscan(const Params& p) {
  bf16_t* CT = (bf16_t*)actp(p, MA_CT); float* NL = (float*)actp(p, MA_NL); const float* DEC = (const float*)actp(p, MA_DEC);
  const int gt = blockIdx.x * 256 + tidx(), nth = gridDim.x * 256;
  for (int e = gt; e < 16 * 4096; e += nth) {
    const int seq = e >> 12, idx = (e & 4095) * 8;
    float run[8];
#pragma unroll
    for (int i = 0; i < 8; ++i) run[i] = 0.f;
    bf16_t* base = CT + (size_t)seq * 66 * 32768 + idx;
#pragma unroll 1
    for (int c0 = 0; c0 < 66; c0 += 11) {
      uint4 d[11]; float dc[11];
#pragma unroll
      for (int q = 0; q < 11; ++q) { d[q] = *(const uint4*)(base + (size_t)(c0 + q) * 32768); dc[q] = DEC[seq * 66 + c0 + q]; }
#pragma unroll
      for (int q = 0; q < 11; ++q) {
        *(uint4*)(base + (size_t)(c0 + q) * 32768) = make_uint4(pk2(run[0], run[1]), pk2(run[2], run[3]), pk2(run[4], run[5]), pk2(run[6], run[7]));
        const float dec = dc[q];
        run[0] = dec * run[0] + bflo(d[q].x); run[1] = dec * run[1] + bfhi(d[q].x); run[2] = dec * run[2] + bflo(d[q].y); run[3] = dec * run[3] + bfhi(d[q].y);
        run[4] = dec * run[4] + bflo(d[q].z); run[5] = dec * run[5] + bfhi(d[q].z); run[6] = dec * run[6] + bflo(d[q].w); run[7] = dec * run[7] + bfhi(d[q].w);
      }
    }
  }
  if (tidx() < 4) {
    for (int e = blockIdx.x * 4 + tidx(); e < 16 * 128; e += gridDim.x * 4) {
      const int seq = e >> 7, k = e & 127; float run = 0.f;
#pragma unroll 1
      for (int c0 = 0; c0 < 66; c0 += 11) {
        float d[11], dc[11];
#pragma unroll
        for (int q = 0; q < 11; ++q) { d[q] = NL[(size_t)(seq * 66 + c0 + q) * 128 + k]; dc[q] = DEC[seq * 66 + c0 + q]; }
#pragma unroll
        for (int q = 0; q < 11; ++q) { NL[(size_t)(seq * 66 + c0 + q) * 128 + k] = run; run = dc[q] * run + d[q]; }
      }
    }
  }
}
DI void phase_ml_out(const Params& p, unsigned char* smem) {
  const bf16_t* QB = (const bf16_t*)actp(p, MA_Q); const bf16_t* KB = (const bf16_t*)actp(p, MA_K); const bf16_t* VB = (const bf16_t*)actp(p, MA_V);
  const float* GT = (const float*)actp(p, MA_GT); const bf16_t* CT = (const bf16_t*)actp(p, MA_CT); const float* NL = (const float*)actp(p, MA_NL);
  const int tid = tidx(), lane = tid & 63, wv = tid >> 6, r32 = lane & 31, hh = lane >> 5;
  unsigned char* sVT = smem + 34816;
  float* bc = (float*)(smem + 69632); float* li = bc + 128; float* tmp = li + 128; float* n0s = tmp + 128;
  for (int item = blockIdx.x; item < 16 * 66; item += gridDim.x) {
    const int seq = item / 66, c = item % 66, dir = seq & 1, bh = seq >> 1, b = bh >> 2, head = bh & 3;
    bf16_t* HD = dir ? (bf16_t*)actp(p, MA_H1) : (bf16_t*)outp(p, 0);
    ml_gates(GT, b, head, dir, c, bc, li, tmp);
    if (tid < 128) n0s[tid] = NL[(size_t)item * 128 + tid];
    __syncthreads();
    const int tq = 32 * wv + r32;
    const int qrow = ml_row(b, dir, c, tq);
    const float btq = bc[tq];
    unsigned char* sP = smem + wv * 8192 + lane * 16;
    float den = 0.f, qn = 0.f;
    {
      bf16x8 Qf[8];
#pragma unroll
      for (int ks = 0; ks < 8; ++ks) Qf[ks] = *(const bf16x8*)(QB + (size_t)qrow * 512 + head * 128 + 16 * ks + 8 * hh);
#pragma unroll
      for (int ks = 0; ks < 8; ++ks)
#pragma unroll
        for (int e = 0; e < 8; ++e) qn += bf2f((unsigned short)Qf[ks][e]) * n0s[16 * ks + 8 * hh + e];
      qn += __shfl_xor(qn, 32);
#pragma unroll 1
      for (int si = 0; si <= wv; ++si) {
        f32x16 sa;
#pragma unroll
        for (int i = 0; i < 16; ++i) sa[i] = 0.f;
        const bf16_t* kr = KB + (size_t)ml_row(b, dir, c, 32 * si + r32) * 512 + head * 128 + 8 * hh;
#pragma unroll
        for (int ks = 0; ks < 8; ++ks) sa = mfma32(*(const bf16x8*)(kr + 16 * ks), Qf[ks], sa);
#pragma unroll
        for (int i = 0; i < 16; ++i) {
          const int sp = 32 * si + (i & 3) + 8 * (i >> 2) + 4 * hh;
          const float f = (sp <= tq) ? __expf(btq - bc[sp] + li[sp]) : 0.f;
          sa[i] *= f; den += sa[i];
        }
        *(bf16x8*)(sP + (2 * si) * 1024) = pack8(sa, 0);
        *(bf16x8*)(sP + (2 * si + 1) * 1024) = pack8(sa, 1);
      }
    }
    den += __shfl_xor(den, 32);
    const float ebt = __expf(btq);
    den = ebt * qn + den;
    const float rden = 1.f / fmaxf(fabsf(den), 1.f);
    const bf16_t* ct = CT + (size_t)item * 32768;
    for (int vh = 0; vh < 2; ++vh) {
      {
        uint4 dv[8];
#pragma unroll
        for (int q = 0; q < 8; ++q) {
          const int cidx = tid + 256 * q, s_ = cidx & 127, vc = cidx >> 7;
          dv[q] = *(const uint4*)(VB + (size_t)ml_row(b, dir, c, s_) * DM + head * 256 + vh * 128 + vc * 8);
        }
#pragma unroll
        for (int q = 0; q < 8; ++q) {
          const int cidx = tid + 256 * q, s_ = cidx & 127, vc = cidx >> 7;
          const unsigned dd[4] = {dv[q].x, dv[q].y, dv[q].z, dv[q].w};
          const int pos = (s_ & ~15) | perm16(s_ & 15);
#pragma unroll
          for (int e = 0; e < 4; ++e) {
            *(bf16_t*)(sVT + (vc * 8 + 2 * e) * 272 + pos * 2) = (bf16_t)(dd[e] & 0xffff);
            *(bf16_t*)(sVT + (vc * 8 + 2 * e + 1) * 272 + pos * 2) = (bf16_t)(dd[e] >> 16);
          }
        }
      }
      __syncthreads();
#pragma unroll 1
      for (int vq = 0; vq < 2; ++vq) {
        f32x16 acc[2];
#pragma unroll
        for (int vi = 0; vi < 2; ++vi)
#pragma unroll
          for (int i = 0; i < 16; ++i) acc[vi][i] = 0.f;
        {
          bf16x8 Qg[8];
#pragma unroll
          for (int ks = 0; ks < 8; ++ks) Qg[ks] = *(const bf16x8*)(QB + (size_t)qrow * 512 + head * 128 + 16 * ks + 8 * hh);
#pragma unroll
          for (int vi = 0; vi < 2; ++vi) {
            const bf16_t* cr = ct + (size_t)(vh * 128 + 64 * vq + 32 * vi + r32) * 128 + 8 * hh;
#pragma unroll
            for (int ks = 0; ks < 8; ++ks) acc[vi] = mfma32(*(const bf16x8*)(cr + 16 * ks), Qg[ks], acc[vi]);
          }
        }
#pragma unroll
        for (int vi = 0; vi < 2; ++vi)
#pragma unroll
          for (int i = 0; i < 16; ++i) acc[vi][i] *= ebt;
#pragma unroll
        for (int kst = 0; kst < 8; ++kst) {
          if (kst < 2 * (wv + 1)) {
            const bf16x8 pf = *(const bf16x8*)(sP + kst * 1024);
#pragma unroll
            for (int vi = 0; vi < 2; ++vi) {
              const bf16x8 vf = *(const bf16x8*)(sVT + (64 * vq + 32 * vi + r32) * 272 + kst * 32 + hh * 16);
              acc[vi] = mfma32(vf, pf, acc[vi]);
            }
          }
        }
#pragma unroll
        for (int vi = 0; vi < 2; ++vi)
#pragma unroll
          for (int ig = 0; ig < 4; ++ig) {
            const int v = vh * 128 + 64 * vq + 32 * vi + 8 * ig + 4 * hh;
            st_bf16x4(HD + (size_t)qrow * DM + head * 256 + v,
                      make_float4(acc[vi][4 * ig] * rden, acc[vi][4 * ig + 1] * rden, acc[vi][4 * ig + 2] * rden, acc[vi][4 * ig + 3] * rden));
          }
      }
      __syncthreads();
    }
  }
}
DI void phase_ml_post(const Params& p, int j) {
  const bf16_t* H0 = (const bf16_t*)outp(p, 0); const bf16_t* H1 = (const bf16_t*)actp(p, MA_H1); const bf16_t* OB = (const bf16_t*)actp(p, MA_O);
  bf16_t* ZB = (bf16_t*)actp(p, MA_ZB);
  const float* ng = p.in[I_MNG] + j * 1024;
  const int lane = tidx() & 63, wid = tidx() >> 6;
  for (int row = blockIdx.x * 4 + wid; row < T_ALL; row += gridDim.x * 4) {
    const int c0 = 16 * lane;
    const size_t off = (size_t)row * DM + c0;
    const uint4 a0 = *(const uint4*)(H0 + off), a1 = *(const uint4*)(H0 + off + 8), b0 = *(const uint4*)(H1 + off), b1 = *(const uint4*)(H1 + off + 8);
    const uint4 o0 = *(const uint4*)(OB + off), o1 = *(const uint4*)(OB + off + 8);
    const unsigned ya[8] = {a0.x, a0.y, a0.z, a0.w, a1.x, a1.y, a1.z, a1.w}, yb[8] = {b0.x, b0.y, b0.z, b0.w, b1.x, b1.y, b1.z, b1.w},
                   oo[8] = {o0.x, o0.y, o0.z, o0.w, o1.x, o1.y, o1.z, o1.w};
    float y[16], q = 0.f;
#pragma unroll
    for (int e = 0; e < 8; ++e) { y[2 * e] = bflo(ya[e]) + bflo(yb[e]); y[2 * e + 1] = bfhi(ya[e]) + bfhi(yb[e]); q += y[2 * e] * y[2 * e] + y[2 * e + 1] * y[2 * e + 1]; }
    q = allreduce16(q);
    const float rs = __builtin_amdgcn_rsqf(q * (1.f / 256.f) + 1e-6f);
    unsigned o[8];
#pragma unroll
    for (int e = 0; e < 8; ++e) {
      const int c = c0 + 2 * e;
      o[e] = pk2(y[2 * e] * rs * ng[c] * bflo(oo[e]), y[2 * e + 1] * rs * ng[c + 1] * bfhi(oo[e]));
    }
    *(uint4*)(ZB + off) = make_uint4(o[0], o[1], o[2], o[3]);
    *(uint4*)(ZB + off + 8) = make_uint4(o[4], o[5], o[6], o[7]);
  }
}

constexpr size_t DA_HB = 0, DA_Q = 33, DA_K = 66, DA_VT = 99, DA_OB = 132;
constexpr int AT_K = 64 * 272, AT_V = 128 * 144, AT_BUF = AT_K + AT_V;
DI void phase_da_qkv(const Params& p, unsigned char* smem) {
  const bf16_t* wb = (const bf16_t*)(wsp(p) + OFF_WB);
  EpiDaQkv epi{(bf16_t*)actp(p, DA_Q), (bf16_t*)actp(p, DA_K), (bf16_t*)actp(p, DA_VT)};
  XCD_FOR(t, 64 * 24) { const int g = t / 192, idx = t % 192; gemm_tile_big(smem, (const bf16_t*)actp(p, DA_HB), DM, wb + DA_QKV, DM, 1024, 8 * g + (idx & 7), idx >> 3, epi); }
  XCD_FOR(t, 96) gemm_tile<false>(smem, (const bf16_t*)actp(p, DA_HB), nullptr, nullptr, DM, wb + DA_QKV, DM, 1024, 128 + (t & 3), t >> 2, epi);
}
DI void phase_da_attn(const Params& p, int j, unsigned char* smem) {
  const bf16_t* QB = (const bf16_t*)actp(p, DA_Q); const bf16_t* KB = (const bf16_t*)actp(p, DA_K); const bf16_t* VT = (const bf16_t*)actp(p, DA_VT);
  bf16_t* OB = (bf16_t*)actp(p, DA_OB);
  const int tid = tidx(), lane = tid & 63, wv = tid >> 6, r32 = lane & 31, hh = lane >> 5;
  const int qh = wv & 1, mp = wv >> 1;
  const float lambda_init = 0.47071301834358416f;
  float lam_full;
  {
    const float* lm = p.in[I_DLAM] + (size_t)j * 256;
    float d1 = 0.f, d2 = 0.f;
    for (int i = 0; i < 64; ++i) { d1 += lm[i] * lm[64 + i]; d2 += lm[128 + i] * lm[192 + i]; }
    lam_full = __expf(d1) - __expf(d2) + lambda_init;
  }
  const float* ng = p.in[I_DNG] + (size_t)j * 128;
  const float csc = 0.125f * 1.4426950408889634f;
  XCD_FOR(slot, 2048 + 64) {
    const int xq = slot / 264, iq = slot - xq * 264;
    const int item = iq < 256 ? xq * 256 + iq : 2048 + xq * 8 + (iq - 256);
    int bh, qbase, kt0, nkt;
    if (item < 2048) { bh = item >> 7; qbase = (bh >> 3) * 8192 + 64 * (item & 127); kt0 = 0; nkt = 132; }
    else { const int it = item - 2048; bh = it >> 2; qbase = T_LAT + (bh >> 3) * 256 + 64 * (it & 3); kt0 = 128; nkt = 4; }
    const int b = bh >> 3, head = bh & 7;
    const int qrow = qbase + 32 * qh + r32;
    bf16x8 Qf[4];
#pragma unroll
    for (int ks = 0; ks < 4; ++ks) Qf[ks] = *(const bf16x8*)(QB + (size_t)qrow * DM + head * 128 + 64 * mp + 16 * ks + 8 * hh);
    f32x16 O[4];
#pragma unroll
    for (int vi = 0; vi < 4; ++vi)
#pragma unroll
      for (int i = 0; i < 16; ++i) O[vi][i] = 0.f;
    float mrun = -1e30f, lsum = 0.f;
    uint4 rk0, rk1, rk2, rk3, rv0, rv1, rv2, rv3;
    const int krow_l = tid >> 4, kcc = tid & 15, vrow_l = tid >> 3, vcc = tid & 7;
#define AT_GLOAD(kt_) do { const int kt__ = (kt_); const int krow0 = kt__ < 128 ? b * 8192 + 64 * kt__ : T_LAT + b * 256 + 64 * (kt__ - 128); \
      const bf16_t* kp_ = KB + (size_t)(krow0 + krow_l) * DM + head * 128 + kcc * 8; \
      const bf16_t* vp_ = VT + ((size_t)bh * 128 + vrow_l) * 8448 + 64 * kt__ + vcc * 8; \
      rk0 = *(const uint4*)(kp_); rk1 = *(const uint4*)(kp_ + 16 * DM); rk2 = *(const uint4*)(kp_ + 32 * DM); rk3 = *(const uint4*)(kp_ + 48 * DM); \
      rv0 = *(const uint4*)(vp_); rv1 = *(const uint4*)(vp_ + 32 * 8448); rv2 = *(const uint4*)(vp_ + 64 * 8448); rv3 = *(const uint4*)(vp_ + 96 * 8448); } while (0)
#define AT_LWRITE(buf_) do { unsigned char* kb_ = smem + (buf_) * AT_BUF + krow_l * 272 + kcc * 16; unsigned char* vb_ = smem + (buf_) * AT_BUF + AT_K + vrow_l * 144 + vcc * 16; \
      *(uint4*)(kb_) = rk0; *(uint4*)(kb_ + 16 * 272) = rk1; *(uint4*)(kb_ + 32 * 272) = rk2; *(uint4*)(kb_ + 48 * 272) = rk3; \
      *(uint4*)(vb_) = rv0; *(uint4*)(vb_ + 32 * 144) = rv1; *(uint4*)(vb_ + 64 * 144) = rv2; *(uint4*)(vb_ + 96 * 144) = rv3; } while (0)
    AT_GLOAD(kt0); AT_LWRITE(0);
    __syncthreads();
    for (int it = 0; it < nkt; ++it) {
      const bool more = it + 1 < nkt;
      if (more) AT_GLOAD(kt0 + it + 1);
      const unsigned char* sK = smem + (it & 1) * AT_BUF; const unsigned char* sV = sK + AT_K;
      f32x16 s0, s1;
#pragma unroll
      for (int i = 0; i < 16; ++i) { s0[i] = 0.f; s1[i] = 0.f; }
#pragma unroll
      for (int ks = 0; ks < 4; ++ks) {
        const bf16x8 k0 = *(const bf16x8*)(sK + r32 * 272 + mp * 128 + ks * 32 + hh * 16);
        const bf16x8 k1 = *(const bf16x8*)(sK + (32 + r32) * 272 + mp * 128 + ks * 32 + hh * 16);
        s0 = mfma32(k0, Qf[ks], s0); s1 = mfma32(k1, Qf[ks], s1);
      }
      float mx = s0[0];
#pragma unroll
      for (int i = 1; i < 16; ++i) mx = fmaxf(mx, s0[i]);
#pragma unroll
      for (int i = 0; i < 16; ++i) mx = fmaxf(mx, s1[i]);
      mx = fmaxf(mx, __shfl_xor(mx, 32));
      const float mnew = fmaxf(mrun, mx * csc);
      if (__any(mnew > mrun)) {
        const float alpha = __builtin_amdgcn_exp2f(mrun - mnew);
        lsum *= alpha;
#pragma unroll
        for (int vi = 0; vi < 4; ++vi)
#pragma unroll
          for (int i = 0; i < 16; ++i) O[vi][i] *= alpha;
      }
      mrun = mnew;
      float ps = 0.f;
#pragma unroll
      for (int i = 0; i < 16; ++i) { s0[i] = __builtin_amdgcn_exp2f(s0[i] * csc - mnew); s1[i] = __builtin_amdgcn_exp2f(s1[i] * csc - mnew); ps += s0[i] + s1[i]; }
      lsum += ps;
      bf16x8 Pf[4];
      Pf[0] = pack8(s0, 0); Pf[1] = pack8(s0, 1); Pf[2] = pack8(s1, 0); Pf[3] = pack8(s1, 1);
#pragma unroll
      for (int kst = 0; kst < 4; ++kst)
#pragma unroll
        for (int vi = 0; vi < 4; ++vi) {
          const bf16x8 vf = *(const bf16x8*)(sV + (32 * vi + r32) * 144 + kst * 32 + hh * 16);
          O[vi] = mfma32(vf, Pf[kst], O[vi]);
        }
      if (more) AT_LWRITE((it + 1) & 1);
      __syncthreads();
    }
    lsum += __shfl_xor(lsum, 32);
    const float rl = 1.f / lsum;
    float* osh = (float*)smem;
    if (mp == 1) {
#pragma unroll
      for (int vi = 0; vi < 4; ++vi)
#pragma unroll
        for (int i = 0; i < 16; ++i) osh[(32 * qh + r32) * 129 + 32 * vi + (i & 3) + 8 * (i >> 2) + 4 * hh] = O[vi][i] * rl;
    }
    __syncthreads();
    if (mp == 0) {
      float ss = 0.f;
#pragma unroll
      for (int vi = 0; vi < 4; ++vi)
#pragma unroll
        for (int i = 0; i < 16; ++i) {
          const float o = O[vi][i] * rl - lam_full * osh[(32 * qh + r32) * 129 + 32 * vi + (i & 3) + 8 * (i >> 2) + 4 * hh];
          O[vi][i] = o; ss += o * o;
        }
      ss += __shfl_xor(ss, 32);
      const float rs = __builtin_amdgcn_rsqf(ss * (1.f / 128.f) + 1e-5f) * (1.f - lambda_init);
#pragma unroll
      for (int vi = 0; vi < 4; ++vi)
#pragma unroll
        for (int ig = 0; ig < 4; ++ig) {
          const int v = 32 * vi + 8 * ig + 4 * hh;
          const float4 g4 = *(const float4*)(ng + v);
          st_bf16x4(OB + (size_t)qrow * DM + head * 128 + v,
                    make_float4(O[vi][4 * ig] * rs * g4.x, O[vi][4 * ig + 1] * rs * g4.y, O[vi][4 * ig + 2] * rs * g4.z, O[vi][4 * ig + 3] * rs * g4.w));
        }
    }
    __syncthreads();
  }
}

DI void phase_final(const Params& p) {
  const float* xr = (const float*)(wsp(p) + OFF_XR);
  const int lane = tidx() & 63, wid = tidx() >> 6;
  for (int row = (blockIdx.x * 4 + wid) * 2; row < T_LAT; row += gridDim.x * 8) {
    float va[16], vb[16];
    norm_load(xr + (size_t)row * DM, lane, va);
    norm_load(xr + (size_t)(row + 1) * DM, lane, vb);
    norm_finish(p.in[I_FING], nullptr, nullptr, lane, va);
    norm_finish(p.in[I_FING], nullptr, nullptr, lane, vb);
#pragma unroll
    for (int j = 0; j < 4; ++j) {
      *(float4*)(p.out + (size_t)row * DM + 4 * lane + 256 * j) = make_float4(va[4 * j], va[4 * j + 1], va[4 * j + 2], va[4 * j + 3]);
      *(float4*)(p.out + (size_t)(row + 1) * DM + 4 * lane + 256 * j) = make_float4(vb[4 * j], vb[4 * j + 1], vb[4 * j + 2], vb[4 * j + 3]);
    }
  }
}

constexpr size_t FA_HB = 0, FA_VG = 33;
DI void run_ffn(const Params& p, int layer, int sub, unsigned char* smem) {
  const int rt = (layer == 3) ? 128 : 132;
  const bf16_t* wb = (const bf16_t*)(wsp(p) + OFF_WB);
  if (sub == 0) phase_norm(p, layer, 1, (bf16_t*)actp(p, FA_HB), rt * 128);
  else if (sub == 1) phase_ffn_in(p, smem, (const bf16_t*)actp(p, FA_HB), (bf16_t*)actp(p, FA_VG), rt);
  else if (sub == 2) phase_ffn_act(p, layer, (bf16_t*)actp(p, FA_VG), rt * 128);
  else phase_gemm_resid(p, smem, layer, (const bf16_t*)actp(p, FA_VG), 5632, 2816, wb + W_FOUT, 5, rt);
}
DI void run_phase(const Params& p, int ph, unsigned char* smem, int rep = 0) {
  const bf16_t* wb = (const bf16_t*)(wsp(p) + OFF_WB);
  if (ph == 0) { phase0(p, smem); return; }
  if (ph == NPH - 1) { phase_final(p); return; }
  int layer, sub;
  if (ph < 12) { layer = 0; sub = ph - 1; } else if (ph < 23) { layer = 1; sub = ph - 12; } else if (ph < 31) { layer = 2; sub = ph - 23; } else { layer = 3; sub = ph - 31; }
  const int kind = layer % 3, j = layer / 3;
  if (kind == 0) {
    if (sub == 0) { convert_weights(p, layer, smem, 2, 99); phase_norm_shift(p, layer, (bf16_t*)actp(p, RA_HB), (bf16_t*)actp(p, RA_XX), p.in[I_RMIX] + (size_t)j * 6 * 1024, (bf16_t*)actp(p, 165), (bf16_t*)actp(p, 198), (bf16_t*)actp(p, 231)); }
    else if (sub == 1) phase_rwkv_proj1(p, j, smem);
    else if (sub == 2) phase_rwkv_proj2(p, j, smem);
    else if (sub == 3) phase_rwkv_scan(p, j, smem, j + 2 * rep);
    else if (sub == 4) phase_rwkv_post(p, j, layer == 3 ? T_LAT : T_ALL);
    else if (sub == 5) phase_rwkv_gate(p, smem, layer == 3 ? 128 : 132);
    else if (sub == 6) phase_gemm_resid(p, smem, layer, (const bf16_t*)actp(p, RA_ZB), 1024, 1024, wb + RW_OUT, 2, layer == 3 ? 128 : 132);
    else run_ffn(p, layer, sub - 7, smem);
  } else if (kind == 1) {
    if (sub == 0) { convert_weights(p, layer, smem); phase_norm(p, layer, 0, (bf16_t*)actp(p, MA_HB)); }
    else if (sub == 1) phase_ml_in(p, j, smem);
    else if (sub == 2) phase_ml_cloc(p, smem);
    else if (sub == 3) phase_ml_cscan(p);
    else if (sub == 4) phase_ml_out(p, smem);
    else if (sub == 5) phase_ml_post(p, j);
    else if (sub == 6) phase_gemm_resid(p, smem, layer, (const bf16_t*)actp(p, MA_ZB), 1024, 1024, wb + ML_WO, 2);
    else run_ffn(p, layer, sub - 7, smem);
  } else {
    if (sub == 0) { convert_weights(p, layer, smem); phase_norm(p, layer, 0, (bf16_t*)actp(p, DA_HB)); }
    else if (sub == 1) phase_da_qkv(p, smem);
    else if (sub == 2) phase_da_attn(p, j, smem);
    else if (sub == 3) phase_gemm_resid(p, smem, layer, (const bf16_t*)actp(p, DA_OB), 1024, 1024, wb + DA_WO, 2);
    else run_ffn(p, layer, sub - 4, smem);
  }
}


#define XB_TMO      128
#define XB_XCNT(j)  (256  + 64 * (j))
#define XB_XSUB(j)  (1280 + 64 * (j))
#define XB_XGEN(j)  (2304 + 64 * (j))
#define XB_TOP      3328
#define XB_TOPGEN   3392
#define XCD_BAR_WORDS 3456
#define XB_SPIN_CAP (1u << 20)
#define LAS __attribute__((address_space(3)))
constexpr size_t MISC_BAR = 768 * 1024;
DI unsigned xb_ld(unsigned* p)              { return __hip_atomic_load(p, __ATOMIC_RELAXED, __HIP_MEMORY_SCOPE_AGENT); }
DI unsigned xb_add(unsigned* p, unsigned v) { return __hip_atomic_fetch_add(p, v, __ATOMIC_RELAXED, __HIP_MEMORY_SCOPE_AGENT); }
DI unsigned xb_xcc_id() { return (unsigned)__builtin_amdgcn_s_getreg((3 << 11) | 20) & 0xFu; }
#define XB_SPIN(cond, bar) do { unsigned _sp = 0; while (cond) { __builtin_amdgcn_s_sleep(1); \
    if ((++_sp & 255u) == 0u) { if (xb_ld(&(bar)[XB_TMO])) break; if (_sp > XB_SPIN_CAP) { atomicAdd(&(bar)[XB_TMO], 1u); break; } } } } while (0)
struct XcdBarrier { unsigned* bar; unsigned x; volatile LAS unsigned* st; };
DI XcdBarrier xcd_barrier_post(unsigned* bar, volatile LAS unsigned* st) {
  XcdBarrier b; b.bar = bar; b.x = xb_xcc_id(); b.st = st;
  if (threadIdx.x == 0) (void)xb_add(&bar[XB_XCNT(b.x)], 1u);
  return b;
}
DI void xcd_barrier_complete(unsigned* bar, unsigned x, unsigned& nloc, unsigned& nx) {
  const unsigned G = gridDim.x * gridDim.y * gridDim.z;
  unsigned sum, cnt, mine, sp = 0u;
  for (;;) {
    sum = 0u; cnt = 0u; mine = 0u;
#pragma unroll
    for (unsigned j = 0; j < 16; ++j) { const unsigned c = xb_ld(&bar[XB_XCNT(j)]); sum += c; cnt += (c > 0u) ? 1u : 0u; mine = (j == x) ? c : mine; }
    if (sum == G) break;
    __builtin_amdgcn_s_sleep(1);
    if ((++sp & 255u) == 0u) { if (xb_ld(&bar[XB_TMO])) break; if (sp > XB_SPIN_CAP) { atomicAdd(&bar[XB_TMO], 1u); break; } }
  }
  nloc = mine > 0u ? mine : 1u; nx = cnt > 0u ? cnt : 1u;
}
DI void xcd_barrier(const XcdBarrier& b) {
  asm volatile("s_waitcnt vmcnt(0)" ::: "memory");
  __syncthreads();
  if (threadIdx.x == 0) {
    unsigned* bar = b.bar;
    __builtin_amdgcn_s_waitcnt(0);
    unsigned nloc = b.st[0], nx = b.st[1];
    if (nloc == 0u) { xcd_barrier_complete(bar, b.x, nloc, nx); b.st[0] = nloc; b.st[1] = nx; }
    const unsigned old = xb_add(&bar[XB_XSUB(b.x)], 1u);
    const unsigned gen = old / nloc;
    if (old + 1u == (gen + 1u) * nloc) {
      __builtin_amdgcn_fence(__ATOMIC_RELEASE, "agent");
      asm volatile("s_waitcnt vmcnt(0)" ::: "memory");
      const unsigned og = xb_add(&bar[XB_TOP], 1u);
      const unsigned tg = og / nx;
      if (og + 1u == (tg + 1u) * nx) xb_add(&bar[XB_TOPGEN], 1u);
      else XB_SPIN(xb_ld(&bar[XB_TOPGEN]) == tg, bar);
      __builtin_amdgcn_fence(__ATOMIC_ACQUIRE, "agent");
      xb_add(&bar[XB_XGEN(b.x)], 1u);
      asm volatile("s_waitcnt vmcnt(0)" ::: "memory");
    } else {
      XB_SPIN(xb_ld(&bar[XB_XGEN(b.x)]) == gen, bar);
      __builtin_amdgcn_fence(__ATOMIC_ACQUIRE, "agent");
      asm volatile("s_waitcnt vmcnt(0)" ::: "memory");
    }
  }
  __syncthreads();
}

__global__ void __launch_bounds__(256, 2) mega(Params p) {
  __shared__ __attribute__((aligned(16))) unsigned char smem[SMEM_BYTES];
  __shared__ uint4 xb_words;
  cg::grid_group grid = cg::this_grid();
  if (threadIdx.x == 0) xb_words = make_uint4(0u, 0u, 0u, 0u);
  __syncthreads();
  const XcdBarrier xb = xcd_barrier_post((unsigned*)(p.ws + OFF_MISC + MISC_BAR), (volatile LAS unsigned*)&xb_words);
  for (int ph = p.ph_lo; ph < p.ph_hi; ++ph) {
    run_phase(p, ph, smem);
    if (ph + 1 < p.ph_hi) { if (ph == p.ph_lo) grid.sync(); else xcd_barrier(xb); }
  }
}

extern "C" void kernel_launch(void* const* d_in, const int* in_sizes, int n_in, void* d_out, int out_size, void* d_ws, size_t ws_size, hipStream_t stream) {
  static int grid_blocks = 0;
  if (!grid_blocks) {
    int dev = 0, cus = 0, per_cu = 0;
    (void)hipGetDevice(&dev);
    (void)hipDeviceGetAttribute(&cus, hipDeviceAttributeMultiprocessorCount, dev);
    (void)hipOccupancyMaxActiveBlocksPerMultiprocessor(&per_cu, mega, 256, 0);
    if (per_cu < 1) per_cu = 1;
    if (per_cu > 2) per_cu = 2;
    grid_blocks = cus * per_cu;
  }
  if (ws_size < (size_t)358 * MiB || out_size < 16384 * 1024) { fprintf(stderr, "workspace too small: %zu\n", ws_size); return; }
  Params p;
  memset(&p, 0, sizeof(p));
  for (int i = 0; i < 37; ++i) p.in[i] = (const float*)d_in[i];
  p.out = (float*)d_out;
  p.ws = (unsigned char*)d_ws;
  p.ph_lo = 0; p.ph_hi = NPH;
  (void)hipMemsetAsync((unsigned char*)d_ws + OFF_MISC + MISC_BAR, 0, XCD_BAR_WORDS * 4, stream);
  void* args[] = {&p};
  hipError_t e = hipLaunchCooperativeKernel((void*)mega, dim3(grid_blocks), dim3(256), args, 0, stream);
  if (e != hipSuccess) fprintf(stderr, "cooperative launch failed: %s (grid %d)\n", hipGetErrorString(e), grid_blocks);
}
```
